# Optimizing an MI355X kernel written in HIP

```python
import math
import jax, jax.numpy as jnp
from jax import lax
import numpy as np

D_MODEL = 1024
BATCH = 32
SEQ = 2048
DEPTH = 1
DEC_BATCH = 8
DEC_SEQ = 16
PAST_LEN = 4096

CHUNK = 64
D_FF = 2816
SSD_EXPAND = 2
D_INNER = SSD_EXPAND * D_MODEL
SSD_HEAD_DIM = 64
SSD_HEADS = D_INNER // SSD_HEAD_DIM
SSD_GROUPS = 8
SSD_HPG = SSD_HEADS // SSD_GROUPS
SSD_STATE = 128
CONV_K = 4
CONV_DIM = D_INNER + 2 * SSD_GROUPS * SSD_STATE
POOL_WINDOWS = (2, 4, 8, 16)
POOL_GROUPS = 4
D_POOL = D_MODEL
POOL_GROUP_DIM = D_POOL // POOL_GROUPS
POOL_BUF = max(POOL_WINDOWS) - 1
N_BRANCHES = 2
D_IN_PROJ = D_INNER + CONV_DIM + SSD_HEADS + D_POOL + N_BRANCHES * D_MODEL
EPS = 1e-6

kernel_name = 'streaming_ssd_pool_hybrid_step'


def _rms_norm(x, g):
    xf = x.astype(jnp.float32)
    y = xf * lax.rsqrt(jnp.mean(xf * xf, axis=-1, keepdims=True) + EPS)
    return (y * g.astype(jnp.float32)).astype(x.dtype)


def _grouped_rms_norm(x, g):
    b, t, _ = x.shape
    xf = x.astype(jnp.float32).reshape(b, t, SSD_GROUPS, D_INNER // SSD_GROUPS)
    y = xf * lax.rsqrt(jnp.mean(xf * xf, axis=-1, keepdims=True) + EPS)
    return (y.reshape(b, t, D_INNER) * g.astype(jnp.float32)).astype(x.dtype)


def _swiglu(x, w_gate, w_up, w_down):
    return (jax.nn.silu(x @ w_gate) * (x @ w_up)) @ w_down


def _causal_dwconv(x, buf, w, b):
    t = x.shape[1]
    xp = jnp.concatenate([buf.astype(x.dtype), x], axis=1)
    out = b.astype(x.dtype)
    for k in range(CONV_K):
        out = out + xp[:, k:k + t] * w[k]
    return out, xp[:, -(CONV_K - 1):]


def _ssd_scan(xh, dt, a, bm, cm, h0):
    b, t = xh.shape[0], xh.shape[1]
    blk = min(CHUNK, t)
    nc = t // blk
    xg = xh.reshape(b, nc, blk, SSD_GROUPS, SSD_HPG, SSD_HEAD_DIM)
    dtg = dt.reshape(b, nc, blk, SSD_GROUPS, SSD_HPG)
    bc = bm.reshape(b, nc, blk, SSD_GROUPS, SSD_STATE)
    cc = cm.reshape(b, nc, blk, SSD_GROUPS, SSD_STATE)
    a_cs = jnp.cumsum(dtg * a.reshape(SSD_GROUPS, SSD_HPG), axis=2)
    xdt = xg * dtg[..., None]
    seg = a_cs[:, :, :, None] - a_cs[:, :, None, :]
    causal = jnp.tril(jnp.ones((blk, blk), dtype=bool))[:, :, None, None]
    decay = jnp.exp(jnp.where(causal, seg, -jnp.inf))
    scores = jnp.einsum('bclgn,bcsgn->bclsg', cc, bc)
    y_diag = jnp.einsum('bclsg,bclsgh,bcsghp->bclghp', scores, decay, xdt)
    decay_to_end = jnp.exp(a_cs[:, :, -1:] - a_cs)
    blk_states = jnp.einsum('bclgn,bclgh,bclghp->bcghpn', bc, decay_to_end, xdt)
    blk_decay = jnp.exp(a_cs[:, :, -1])

    def step(h, inp):
        st, dec = inp
        return dec[..., None, None] * h + st, h

    h0g = h0.reshape(b, SSD_GROUPS, SSD_HPG, SSD_HEAD_DIM, SSD_STATE)
    h_fin, h_prev = lax.scan(step, h0g, (jnp.moveaxis(blk_states, 1, 0), jnp.moveaxis(blk_decay, 1, 0)))
    h_prev = jnp.moveaxis(h_prev, 0, 1)
    y_off = jnp.einsum('bclgn,bclgh,bcghpn->bclghp', cc, jnp.exp(a_cs), h_prev)
    y = (y_diag + y_off).reshape(b, t, SSD_HEADS, SSD_HEAD_DIM)
    return y, h_fin.reshape(b, SSD_HEADS, SSD_HEAD_DIM, SSD_STATE)


def _multiscale_pool(u, buf, pos0):
    t = u.shape[1]
    up = jnp.concatenate([buf.astype(u.dtype), u], axis=1)
    cs = jnp.cumsum(up.astype(jnp.float32), axis=1)
    cs = jnp.pad(cs, ((0, 0), (1, 0), (0, 0)))
    pos = pos0 + jnp.arange(t, dtype=jnp.int32)
    outs = []
    for gi, k in enumerate(POOL_WINDOWS):
        sl = slice(gi * POOL_GROUP_DIM, (gi + 1) * POOL_GROUP_DIM)
        lo = POOL_BUF + 1 - k
        wsum = cs[:, POOL_BUF + 1:POOL_BUF + 1 + t, sl] - cs[:, lo:lo + t, sl]
        cnt = jnp.minimum(pos + 1, k).astype(jnp.float32)[None, :, None]
        outs.append(wsum / cnt)
    pooled = jnp.concatenate(outs, axis=-1).astype(u.dtype) - u
    return pooled, up[:, -POOL_BUF:]


def _mixer(h, conv_buf, ssm_state, pool_buf, pos0, p):
    b, t, _ = h.shape
    proj = h @ p['w_in']
    cuts = np.cumsum([D_INNER, CONV_DIM, SSD_HEADS, D_POOL, D_MODEL]).tolist()
    z, xbc, dt_raw, u_pool, g_a, g_b = jnp.split(proj, cuts, axis=-1)
    xbc, new_conv = _causal_dwconv(xbc, conv_buf, p['conv_w'], p['conv_b'])
    xbc = jax.nn.silu(xbc)
    xs, bm, cm = jnp.split(xbc, [D_INNER, D_INNER + SSD_GROUPS * SSD_STATE], axis=-1)
    xh = xs.reshape(b, t, SSD_HEADS, SSD_HEAD_DIM).astype(jnp.float32)
    dt = jax.nn.softplus(dt_raw.astype(jnp.float32) + p['dt_bias'].astype(jnp.float32))
    a = -jnp.exp(p['a_log'].astype(jnp.float32))
    y, new_ssm = _ssd_scan(xh, dt, a,
                           bm.reshape(b, t, SSD_GROUPS, SSD_STATE).astype(jnp.float32),
                           cm.reshape(b, t, SSD_GROUPS, SSD_STATE).astype(jnp.float32),
                           ssm_state.astype(jnp.float32))
    y = y + p['d_skip'].astype(jnp.float32)[:, None] * xh
    y = y.reshape(b, t, D_INNER).astype(h.dtype) * jax.nn.silu(z)
    y_a = _grouped_rms_norm(y, p['ssd_norm_g']) @ p['w_proj_ssd']
    pooled, new_pool = _multiscale_pool(u_pool, pool_buf, pos0)
    mixed = jnp.einsum('btgc,gcd->btgd', pooled.reshape(b, t, POOL_GROUPS, POOL_GROUP_DIM), p['pool_mix'])
    y_b = (mixed.reshape(b, t, D_POOL) * p['pool_scale']) @ p['w_proj_pool']
    gate_a = jax.nn.sigmoid(g_a.astype(jnp.float32)).astype(h.dtype)
    gate_b = jax.nn.sigmoid(g_b.astype(jnp.float32)).astype(h.dtype)
    out = (gate_a * y_a + gate_b * y_b) @ p['w_out']
    return out, new_conv, new_ssm.astype(ssm_state.dtype), new_pool


def _layer(x, conv_buf, ssm_state, pool_buf, pos0, p):
    f1 = _swiglu(_rms_norm(x, p['ffn1_pre_g']), p['ffn1_w_gate'], p['ffn1_w_up'], p['ffn1_w_down'])
    x = x + 0.5 * _rms_norm(f1, p['ffn1_post_g'])
    m, new_conv, new_ssm, new_pool = _mixer(_rms_norm(x, p['mix_pre_g']), conv_buf, ssm_state, pool_buf, pos0, p)
    x = x + _rms_norm(m, p['mix_post_g'])
    f2 = _swiglu(_rms_norm(x, p['ffn2_pre_g']), p['ffn2_w_gate'], p['ffn2_w_up'], p['ffn2_w_down'])
    x = x + 0.5 * _rms_norm(f2, p['ffn2_post_g'])
    return x, new_conv, new_ssm, new_pool


def setup_inputs(seed: int = 0) -> dict:
    key = jax.random.key(seed)
    ks = jax.random.split(key, 40)

    def nrm(k, shape, scale=1.0):
        return jax.random.normal(k, shape, jnp.float32) * scale

    def gain(k, n):
        return 1.0 + 0.02 * jax.random.normal(k, (DEPTH, n), jnp.float32)

    dt0 = jnp.exp(jax.random.uniform(ks[20], (DEPTH, SSD_HEADS), jnp.float32, math.log(1e-3), math.log(1e-1)))
    return {
        'x_prompt': nrm(ks[0], (BATCH, SEQ, D_MODEL)),
        'x_sample': nrm(ks[1], (DEC_BATCH, DEC_SEQ, D_MODEL)),
        'cache_conv': nrm(ks[2], (DEPTH, DEC_BATCH, CONV_K - 1, CONV_DIM)),
        'state_ssm': nrm(ks[3], (DEPTH, DEC_BATCH, SSD_HEADS, SSD_HEAD_DIM, SSD_STATE), 0.1),
        'cache_pool': nrm(ks[4], (DEPTH, DEC_BATCH, POOL_BUF, D_POOL)),
        'ffn1_pre_g': gain(ks[5], D_MODEL),
        'ffn1_post_g': gain(ks[6], D_MODEL),
        'ffn1_w_gate': nrm(ks[7], (DEPTH, D_MODEL, D_FF), D_MODEL ** -0.5),
        'ffn1_w_up': nrm(ks[8], (DEPTH, D_MODEL, D_FF), D_MODEL ** -0.5),
        'ffn1_w_down': nrm(ks[9], (DEPTH, D_FF, D_MODEL), D_FF ** -0.5),
        'mix_pre_g': gain(ks[10], D_MODEL),
        'mix_post_g': gain(ks[11], D_MODEL),
        'w_in': nrm(ks[12], (DEPTH, D_MODEL, D_IN_PROJ), D_MODEL ** -0.5),
        'conv_w': nrm(ks[13], (DEPTH, CONV_K, CONV_DIM), CONV_K ** -0.5),
        'conv_b': nrm(ks[14], (DEPTH, CONV_DIM), 0.02),
        'dt_bias': dt0 + jnp.log(-jnp.expm1(-dt0)),
        'a_log': jnp.log(jax.random.uniform(ks[15], (DEPTH, SSD_HEADS), jnp.float32, 1.0, 16.0)),
        'd_skip': 1.0 + 0.1 * jax.random.normal(ks[16], (DEPTH, SSD_HEADS), jnp.float32),
        'ssd_norm_g': gain(ks[17], D_INNER),
        'w_proj_ssd': nrm(ks[18], (DEPTH, D_INNER, D_MODEL), D_INNER ** -0.5),
        'pool_mix': nrm(ks[19], (DEPTH, POOL_GROUPS, POOL_GROUP_DIM, POOL_GROUP_DIM), POOL_GROUP_DIM ** -0.5),
        'pool_scale': 1.0 + 0.1 * jax.random.normal(ks[21], (DEPTH, D_POOL), jnp.float32),
        'w_proj_pool': nrm(ks[22], (DEPTH, D_POOL, D_MODEL), D_POOL ** -0.5),
        'w_out': nrm(ks[23], (DEPTH, D_MODEL, D_MODEL), D_MODEL ** -0.5),
        'ffn2_pre_g': gain(ks[24], D_MODEL),
        'ffn2_post_g': gain(ks[25], D_MODEL),
        'ffn2_w_gate': nrm(ks[26], (DEPTH, D_MODEL, D_FF), D_MODEL ** -0.5),
        'ffn2_w_up': nrm(ks[27], (DEPTH, D_MODEL, D_FF), D_MODEL ** -0.5),
        'ffn2_w_down': nrm(ks[28], (DEPTH, D_FF, D_MODEL), D_FF ** -0.5),
    }


def reference(x_prompt, x_sample, cache_conv, state_ssm, cache_pool,
              ffn1_pre_g, ffn1_post_g, ffn1_w_gate, ffn1_w_up, ffn1_w_down,
              mix_pre_g, mix_post_g, w_in, conv_w, conv_b, dt_bias, a_log, d_skip,
              ssd_norm_g, w_proj_ssd, pool_mix, pool_scale, w_proj_pool, w_out,
              ffn2_pre_g, ffn2_post_g, ffn2_w_gate, ffn2_w_up, ffn2_w_down):
    y_p, y_s = x_prompt, x_sample
    bp = x_prompt.shape[0]
    conv_p, ssm_p, pool_p, conv_s, ssm_s, pool_s = [], [], [], [], [], []
    for i in range(DEPTH):
        p = {
            'ffn1_pre_g': ffn1_pre_g[i], 'ffn1_post_g': ffn1_post_g[i],
            'ffn1_w_gate': ffn1_w_gate[i], 'ffn1_w_up': ffn1_w_up[i], 'ffn1_w_down': ffn1_w_down[i],
            'mix_pre_g': mix_pre_g[i], 'mix_post_g': mix_post_g[i], 'w_in': w_in[i],
            'conv_w': conv_w[i], 'conv_b': conv_b[i], 'dt_bias': dt_bias[i], 'a_log': a_log[i],
            'd_skip': d_skip[i], 'ssd_norm_g': ssd_norm_g[i], 'w_proj_ssd': w_proj_ssd[i],
            'pool_mix': pool_mix[i], 'pool_scale': pool_scale[i], 'w_proj_pool': w_proj_pool[i],
            'w_out': w_out[i],
            'ffn2_pre_g': ffn2_pre_g[i], 'ffn2_post_g': ffn2_post_g[i],
            'ffn2_w_gate': ffn2_w_gate[i], 'ffn2_w_up': ffn2_w_up[i], 'ffn2_w_down': ffn2_w_down[i],
        }
        zc = jnp.zeros((bp, CONV_K - 1, CONV_DIM), x_prompt.dtype)
        zs = jnp.zeros((bp, SSD_HEADS, SSD_HEAD_DIM, SSD_STATE), x_prompt.dtype)
        zp = jnp.zeros((bp, POOL_BUF, D_POOL), x_prompt.dtype)
        y_p, c1, s1, q1 = _layer(y_p, zc, zs, zp, 0, p)
        y_s, c2, s2, q2 = _layer(y_s, cache_conv[i], state_ssm[i], cache_pool[i], PAST_LEN, p)
        conv_p.append(c1); ssm_p.append(s1); pool_p.append(q1)
        conv_s.append(c2); ssm_s.append(s2); pool_s.append(q2)
    new_conv_prompt = jnp.stack(conv_p)
    new_ssm_prompt = jnp.stack(ssm_p)
    new_pool_prompt = jnp.stack(pool_p)
    new_conv_sample = jnp.stack(conv_s)
    new_ssm_sample = jnp.stack(ssm_s)
    new_pool_sample = jnp.stack(pool_s)
    return (y_p, y_s, new_conv_prompt, new_ssm_prompt, new_pool_prompt, new_conv_sample, new_ssm_sample, new_pool_sample)
```

```cpp
#include <hip/hip_runtime.h>
#include <hip/hip_cooperative_groups.h>
#include <cstdio>
#include <cstdint>
namespace cg = cooperative_groups;
namespace pg8 {
#define PG8_LAS __attribute__((address_space(3)))
typedef unsigned short bf16_t;
typedef short bf16x8 __attribute__((ext_vector_type(8)));
typedef float f32x4 __attribute__((ext_vector_type(4)));
typedef unsigned u32x4 __attribute__((ext_vector_type(4)));
constexpr int BM = 256, BK = 64, HALF = 128, HTB = HALF * BK * 2  , STAGE_BYTES = 8 * HTB, NXCD = 8, WGM = 8;

__host__ __device__ __forceinline__ int lds_byte(int r, int c) { const int st = (r >> 4) * 2 + (c >> 5), rr = r & 15, cc = c & 31, ob = rr * 64 + cc * 2; return st * 1024 + (ob ^ (((ob >> 9) & 1) << 5)); }
__host__ __device__ __forceinline__ void stage_rc(int b, int& R, int& C) { const int st = b / 1024, sb = b % 1024, swz = sb ^ (((sb >> 9) & 1) << 5); R = (st >> 1) * 16 + swz / 64; C = (st & 1) * 32 + (swz % 64) / 2; }
__host__ __device__ __forceinline__ int perm32(int rho) { const int n = rho >> 4, i = rho & 15; return 8 * (i >> 2) + 4 * n + (i & 3); }

struct Unit { int pm, pn; };
struct Gemm { const bf16_t* A; const bf16_t* Bt; int M, N, K; int ablk; };

struct StaticOrder {
    int nM, nN, nwg, G, c;
    __host__ __device__ void init(int M, int N, int G_, int c_) { nM = M / BM; nN = N / BM; nwg = nM * nN; G = G_; c = c_; }
    __host__ __device__ bool next(int i, Unit& u) const {
        const long L = (long)i * G + c; if (L >= nwg) return false;
        int wgid = (int)L; { const int q = nwg / NXCD, r = nwg % NXCD, xcd = wgid % NXCD, off = wgid / NXCD; wgid = (xcd < r ? xcd * (q + 1) : r * (q + 1) + (xcd - r) * q) + off; }
        const int nig = WGM * nN, gid = wgid / nig, fm = gid * WGM, gsz = (nM - fm) < WGM ? (nM - fm) : WGM;
        u.pm = fm + ((wgid % nig) % gsz); u.pn = (wgid % nig) / gsz; return true;
    }
    __device__ __forceinline__ void a_ready(const Unit&) const {}
    __device__ __forceinline__ void done(const Unit&) const {}
};

typedef __bf16 bf16x2_t __attribute__((ext_vector_type(2)));
typedef float f32x2 __attribute__((ext_vector_type(2)));
__device__ __forceinline__ unsigned pk2(float lo, float hi) { f32x2 v = {lo, hi}; bf16x2_t r = __builtin_convertvector(v, bf16x2_t); return __builtin_bit_cast(unsigned, r); }
__device__ __forceinline__ float bflo(unsigned u) { return __uint_as_float(u << 16); }
__device__ __forceinline__ float bfhi(unsigned u) { return __uint_as_float(u & 0xffff0000u); }
__device__ __forceinline__ float fast_sigmoid(float x) { return __builtin_amdgcn_rcpf(1.0f + __builtin_amdgcn_exp2f(-1.44269504089f * x)); }
__device__ __forceinline__ float fast_silu(float x) { return x * fast_sigmoid(x); }
__device__ __forceinline__ f32x4 sigmoid4(f32x4 x) {
    const f32x4 t = x * (-1.44269504089f); f32x4 ex;
    ex[0] = __builtin_amdgcn_exp2f(t[0]); ex[1] = __builtin_amdgcn_exp2f(t[1]); ex[2] = __builtin_amdgcn_exp2f(t[2]); ex[3] = __builtin_amdgcn_exp2f(t[3]);
    const f32x4 d = ex + 1.0f; f32x4 r;
    r[0] = __builtin_amdgcn_rcpf(d[0]); r[1] = __builtin_amdgcn_rcpf(d[1]); r[2] = __builtin_amdgcn_rcpf(d[2]); r[3] = __builtin_amdgcn_rcpf(d[3]);
    return r;
}
__device__ __forceinline__ f32x4 silu4(f32x4 x) {
    const f32x4 t = x * (-1.44269504089f); f32x4 ex;
    ex[0] = __builtin_amdgcn_exp2f(t[0]); ex[1] = __builtin_amdgcn_exp2f(t[1]); ex[2] = __builtin_amdgcn_exp2f(t[2]); ex[3] = __builtin_amdgcn_exp2f(t[3]);
    const f32x4 d = ex + 1.0f; f32x4 r;
    r[0] = __builtin_amdgcn_rcpf(d[0]); r[1] = __builtin_amdgcn_rcpf(d[1]); r[2] = __builtin_amdgcn_rcpf(d[2]); r[3] = __builtin_amdgcn_rcpf(d[3]);
    return x * r;
}

struct EpiBf16 {
    static constexpr bool PERM = true, AFTER_DRAIN = false;
    bf16_t* O; int ldc;
    __device__ __forceinline__ void operator()(const f32x4 (&acc)[2][2][4][2], const Unit& u, int wr, int wc, int fr, int fq) const {
        const int row0 = u.pm * BM + wr * 64 + fr; const int col0 = u.pn * BM + wc * 32 + 8 * fq;
#pragma unroll
        for (int ai = 0; ai < 2; ++ai)
#pragma unroll
            for (int m = 0; m < 4; ++m) { bf16_t* rowp = O + (size_t)(row0 + ai * HALF + m * 16) * ldc + col0;
#pragma unroll
                for (int bj = 0; bj < 2; ++bj) { const f32x4 v0 = acc[ai][bj][m][0], v1 = acc[ai][bj][m][1];
                    u32x4 w; w.x = pk2(v0[0], v0[1]); w.y = pk2(v0[2], v0[3]); w.z = pk2(v1[0], v1[1]); w.w = pk2(v1[2], v1[3]);
                    *(u32x4*)(rowp + bj * HALF) = w; } }
    }
};
struct EpiSwiglu {
    static constexpr bool PERM = false, AFTER_DRAIN = false;
    bf16_t* H; int ldh;
    __device__ __forceinline__ void operator()(const f32x4 (&acc)[2][2][4][2], const Unit& u, int wr, int wc, int fr, int fq) const {
        const int row0 = u.pm * BM + wr * 64 + fr; const int hcol = u.pn * 128 + wc * 32 + 8 * fq;
#pragma unroll
        for (int ai = 0; ai < 2; ++ai)
#pragma unroll
            for (int m = 0; m < 4; ++m) {
                bf16_t* rowp = H + (((size_t)u.pm * (ldh >> 6) + (hcol >> 6)) * BM + (wr * 64 + fr + ai * HALF + m * 16)) * 64 + (hcol & 63);
                const f32x4 g0 = acc[ai][0][m][0], u0 = acc[ai][0][m][1], g1 = acc[ai][1][m][0], u1 = acc[ai][1][m][1];
                const f32x4 h0 = silu4(g0) * u0, h1 = silu4(g1) * u1;
                u32x4 w; w.x = pk2(h0[0], h0[1]); w.y = pk2(h0[2], h0[3]); w.z = pk2(h1[0], h1[1]); w.w = pk2(h1[2], h1[3]);
                *(u32x4*)rowp = w; }
    }
};
struct EpiWin1 {
    static constexpr bool PERM = true, AFTER_DRAIN = false;
    bf16_t* Z; bf16_t* XBC; float* DT; const float* dt_bias;
    __device__ __forceinline__ void operator()(const f32x4 (&acc)[2][2][4][2], const Unit& u, int wr, int wc, int fr, int fq) const {
        const int row0 = u.pm * BM + wr * 64 + fr;
        if (u.pn < 24) {
            bf16_t* base; int ldc, colt;
            if (u.pn < 8) { base = Z; ldc = 2048; colt = u.pn * BM; } else { base = XBC; ldc = 4096; colt = (u.pn - 8) * BM; }
            const int col0 = colt + wc * 32 + 8 * fq;
#pragma unroll
            for (int ai = 0; ai < 2; ++ai)
#pragma unroll
                for (int m = 0; m < 4; ++m) { bf16_t* rowp = base + (size_t)(row0 + ai * HALF + m * 16) * ldc + col0;
#pragma unroll
                    for (int bj = 0; bj < 2; ++bj) { const f32x4 v0 = acc[ai][bj][m][0], v1 = acc[ai][bj][m][1];
                        u32x4 w; w.x = pk2(v0[0], v0[1]); w.y = pk2(v0[2], v0[3]); w.z = pk2(v1[0], v1[1]); w.w = pk2(v1[2], v1[3]);
                        *(u32x4*)(rowp + bj * HALF) = w; } }
        } else if (wc == 0) {
            const int col0 = 8 * fq;
            const f32x4 b0 = *(const f32x4*)(dt_bias + col0), b1 = *(const f32x4*)(dt_bias + col0 + 4);
#pragma unroll
            for (int ai = 0; ai < 2; ++ai)
#pragma unroll
                for (int m = 0; m < 4; ++m) { float* rowp = DT + (size_t)(row0 + ai * HALF + m * 16) * 32 + col0;
                    f32x4 v0 = acc[ai][0][m][0] + b0, v1 = acc[ai][0][m][1] + b1;
#pragma unroll
                    for (int j = 0; j < 4; ++j) { v0[j] = fmaxf(v0[j], 0.f) + log1pf(expf(-fabsf(v0[j]))); v1[j] = fmaxf(v1[j], 0.f) + log1pf(expf(-fabsf(v1[j]))); }
                    *(f32x4*)rowp = v0; *(f32x4*)(rowp + 4) = v1; }
        }
    }
};
struct EpiWin2 {
    static constexpr bool PERM = true, AFTER_DRAIN = false;
    bf16_t* U; size_t stride;
    __device__ __forceinline__ void operator()(const f32x4 (&acc)[2][2][4][2], const Unit& u, int wr, int wc, int fr, int fq) const {
        const int row0 = u.pm * BM + wr * 64 + fr; const int t = u.pn >> 2; const bool sg = t != 0;
        bf16_t* base = U + (size_t)t * stride; const int col0 = (u.pn & 3) * BM + wc * 32 + 8 * fq;
#pragma unroll
        for (int ai = 0; ai < 2; ++ai)
#pragma unroll
            for (int m = 0; m < 4; ++m) { bf16_t* rowp = base + (size_t)(row0 + ai * HALF + m * 16) * 1024 + col0;
#pragma unroll
                for (int bj = 0; bj < 2; ++bj) { f32x4 v0 = acc[ai][bj][m][0], v1 = acc[ai][bj][m][1];
                    if (sg) { v0 = sigmoid4(v0); v1 = sigmoid4(v1); }
                    u32x4 w; w.x = pk2(v0[0], v0[1]); w.y = pk2(v0[2], v0[3]); w.z = pk2(v1[0], v1[1]); w.w = pk2(v1[2], v1[3]);
                    *(u32x4*)(rowp + bj * HALF) = w; } }
    }
};
template <int MODE> struct EpiGate {
    static constexpr bool PERM = true, AFTER_DRAIN = false;
    bf16_t* G; const bf16_t* T;
    __device__ __forceinline__ void operator()(const f32x4 (&acc)[2][2][4][2], const Unit& u, int wr, int wc, int fr, int fq) const {
        const int row0 = u.pm * BM + wr * 64 + fr; const int col0 = u.pn * BM + wc * 32 + 8 * fq;
#pragma unroll
        for (int ai = 0; ai < 2; ++ai)
#pragma unroll
            for (int m = 0; m < 4; ++m) { const size_t off = (size_t)(row0 + ai * HALF + m * 16) * 1024 + col0;
#pragma unroll
                for (int bj = 0; bj < 2; ++bj) { const f32x4 v0 = acc[ai][bj][m][0], v1 = acc[ai][bj][m][1];
                    const u32x4 g = *(const u32x4*)(G + off + bj * HALF);
                    float r[8] = {bflo(g.x) * v0[0], bfhi(g.x) * v0[1], bflo(g.y) * v0[2], bfhi(g.y) * v0[3], bflo(g.z) * v1[0], bfhi(g.z) * v1[1], bflo(g.w) * v1[2], bfhi(g.w) * v1[3]};
                    if (MODE == 1) { const u32x4 t = *(const u32x4*)(T + off + bj * HALF);
                        r[0] += bflo(t.x); r[1] += bfhi(t.x); r[2] += bflo(t.y); r[3] += bfhi(t.y); r[4] += bflo(t.z); r[5] += bfhi(t.z); r[6] += bflo(t.w); r[7] += bfhi(t.w); }
                    u32x4 w; w.x = pk2(r[0], r[1]); w.y = pk2(r[2], r[3]); w.z = pk2(r[4], r[5]); w.w = pk2(r[6], r[7]);
                    *(u32x4*)(G + off + bj * HALF) = w; } }
    }
};

template <class Epi, class Sched, bool ALIGN_EPI = false, bool SP2 = false>
__device__ __forceinline__ void gemm_phase(PG8_LAS unsigned char* lds, const Gemm g, const Sched& S, const Epi& E) {
    int tid_ = threadIdx.x; asm volatile("" : "+v"(tid_));
    const int tid = tid_, wid = __builtin_amdgcn_readfirstlane(tid >> 6), lane = tid & 63, wr = wid >> 2, wc = wid & 3, fr = lane & 15, fq = lane >> 4;
    const int K = g.K, nt = K / BK;
    unsigned voffA[2], voffB[2];
#pragma unroll
    for (int i = 0; i < 2; ++i) { int R, C; stage_rc(tid * 16 + i * 8192, R, C); const int Rb = Epi::PERM ? ((R & ~31) + perm32(R & 31)) : R;
        voffA[i] = g.ablk ? (unsigned)(R * BK + C) * 2u : (unsigned)(R * K + C) * 2u; voffB[i] = (unsigned)(Rb * K + C) * 2u; }
    const size_t kstep = (size_t)(BK * 2);
    const size_t hstep = (size_t)HALF * K * 2;
    const size_t tstep = 2 * hstep;
    const size_t kstepA = g.ablk ? (size_t)(BM * BK * 2) : kstep, hstepA = g.ablk ? (size_t)(HALF * BK * 2) : hstep, tstepA = g.ablk ? (size_t)(K / BK) * (BM * BK * 2) : tstep;
    const unsigned ldsw = (unsigned)wid * 1024u;
    const int aoff = lds_byte(wr * 64 + fr, fq * 8), boff = lds_byte(wc * 32 + fr, fq * 8);
#define PG8_SA(b, h) (((b) * 2 + (h)) * HTB)
#define PG8_SB(b, h) ((4 + (b) * 2 + (h)) * HTB)
#define PG8_STAGE(bufoff, gbase, voff) do { _Pragma("unroll") for (int _i = 0; _i < 2; ++_i) \
        __builtin_amdgcn_global_load_lds((const unsigned*)((const char*)(gbase) + (voff)[_i]), (PG8_LAS unsigned*)(lds + (bufoff) + ldsw + _i * 8192), 16, 0, 0); } while (0)
#define PG8_LDA(dst, b, h) do { _Pragma("unroll") for (int m = 0; m < 4; ++m) _Pragma("unroll") for (int k = 0; k < 2; ++k) dst[m][k] = *(const PG8_LAS bf16x8*)(lds + PG8_SA(b, h) + aoff + m * 2048 + k * 1024); } while (0)
#define PG8_LDB(dst, b, h) do { _Pragma("unroll") for (int n = 0; n < 2; ++n) _Pragma("unroll") for (int k = 0; k < 2; ++k) dst[n][k] = *(const PG8_LAS bf16x8*)(lds + PG8_SB(b, h) + boff + n * 2048 + k * 1024); } while (0)
#define PG8_MMA(ai, bj, At, Bt) do { __builtin_amdgcn_s_setprio(1); _Pragma("unroll") for (int m = 0; m < 4; ++m) _Pragma("unroll") for (int n = 0; n < 2; ++n) _Pragma("unroll") for (int k = 0; k < 2; ++k) \
        acc[ai][bj][m][n] = __builtin_amdgcn_mfma_f32_16x16x32_bf16(Bt[n][k], At[m][k], acc[ai][bj][m][n], 0, 0, 0); __builtin_amdgcn_s_setprio(0); } while (0)
#define PG8_WAIT_V(n) asm volatile("s_waitcnt vmcnt(" #n ")" ::: "memory")
#define PG8_WAIT_L(n) asm volatile("s_waitcnt lgkmcnt(" #n ")" ::: "memory")
#define PG8_BAR __builtin_amdgcn_s_barrier()
#define PG8_SCHED __builtin_amdgcn_sched_barrier(0)
    Unit cur, nxt; int ui = 0;
    if (!S.next(0, cur)) return;
    f32x4 acc[2][2][4][2];
#pragma unroll
    for (int a = 0; a < 2; ++a)
#pragma unroll
        for (int b = 0; b < 2; ++b)
#pragma unroll
            for (int m = 0; m < 4; ++m)
#pragma unroll
                for (int n = 0; n < 2; ++n) acc[a][b][m][n] = (f32x4){0.f, 0.f, 0.f, 0.f};
    bf16x8 At[4][2], B0[2][2], B1[2][2];
    const char* cA = (const char*)g.A + (size_t)cur.pm * tstepA; const char* cB = (const char*)g.Bt + (size_t)cur.pn * tstep;
    S.a_ready(cur);
    if constexpr (SP2) {
        PG8_STAGE(PG8_SB(0, 0), cB, voffB); PG8_STAGE(PG8_SB(0, 1), cB + hstep, voffB); PG8_STAGE(PG8_SA(0, 0), cA, voffA); PG8_STAGE(PG8_SA(0, 1), cA + hstepA, voffA);
        if (wr == 1) PG8_BAR;
        PG8_WAIT_V(2); PG8_BAR;
        PG8_STAGE(PG8_SB(1, 0), cB + kstep, voffB); PG8_STAGE(PG8_SA(1, 0), cA + kstepA, voffA); PG8_STAGE(PG8_SB(1, 1), cB + hstep + kstep, voffB);
        PG8_WAIT_V(6); PG8_BAR;
    } else {
        PG8_STAGE(PG8_SB(0, 0), cB, voffB); PG8_STAGE(PG8_SA(0, 0), cA, voffA); PG8_STAGE(PG8_SB(0, 1), cB + hstep, voffB); PG8_STAGE(PG8_SA(0, 1), cA + hstepA, voffA);
        if (wr == 1) PG8_BAR;
        PG8_WAIT_V(4); PG8_BAR;
        PG8_STAGE(PG8_SB(1, 0), cB + kstep, voffB); PG8_STAGE(PG8_SA(1, 0), cA + kstepA, voffA); PG8_STAGE(PG8_SB(1, 1), cB + hstep + kstep, voffB);
        PG8_WAIT_V(6); PG8_BAR;
    }
    for (;;) {
        const bool has_next = S.next(ui + 1, nxt);
        const char* nA = has_next ? (const char*)g.A + (size_t)nxt.pm * tstepA : cA; const char* nB = has_next ? (const char*)g.Bt + (size_t)nxt.pn * tstep : cB;
        for (int t = 0; t < nt; t += 2) {
            const bool last = (t == nt - 2);
            const char* a1 = cA + (size_t)(t + 1) * kstepA;
            const char* a2 = last ? nA : cA + (size_t)(t + 2) * kstepA; const char* b2 = last ? nB : cB + (size_t)(t + 2) * kstep;
            const char* a3 = a2 + kstepA; const char* b3 = b2 + kstep;
            if (last && has_next) S.a_ready(nxt);
            if constexpr (SP2) {
            PG8_LDB(B0, 0, 0); PG8_LDB(B1, 0, 1); PG8_SCHED; PG8_LDA(At, 0, 0); PG8_STAGE(PG8_SA(1, 1), a1 + hstepA, voffA);
            PG8_WAIT_V(8); PG8_WAIT_L(0); PG8_BAR; PG8_MMA(0, 0, At, B0); PG8_MMA(0, 1, At, B1); PG8_BAR; PG8_SCHED;
            PG8_LDA(At, 0, 1); PG8_STAGE(PG8_SB(0, 0), b2, voffB); PG8_STAGE(PG8_SB(0, 1), b2 + hstep, voffB); PG8_STAGE(PG8_SA(0, 0), a2, voffA);
            PG8_WAIT_V(8); PG8_WAIT_L(0); PG8_BAR; PG8_MMA(1, 0, At, B0); PG8_MMA(1, 1, At, B1); PG8_BAR; PG8_SCHED;
            PG8_LDB(B0, 1, 0); PG8_LDB(B1, 1, 1); PG8_SCHED; PG8_LDA(At, 1, 0); PG8_STAGE(PG8_SA(0, 1), a2 + hstepA, voffA);
            PG8_WAIT_V(8); PG8_WAIT_L(0); PG8_BAR; PG8_MMA(0, 0, At, B0); PG8_MMA(0, 1, At, B1); PG8_BAR; PG8_SCHED;
            PG8_LDA(At, 1, 1); PG8_STAGE(PG8_SB(1, 0), b3, voffB); PG8_STAGE(PG8_SB(1, 1), b3 + hstep, voffB); PG8_STAGE(PG8_SA(1, 0), a3, voffA);
            PG8_WAIT_V(8); PG8_WAIT_L(0); PG8_BAR; PG8_MMA(1, 0, At, B0); PG8_MMA(1, 1, At, B1); PG8_BAR; PG8_SCHED;
            } else {
            PG8_LDB(B0, 0, 0); PG8_SCHED; PG8_LDA(At, 0, 0); PG8_STAGE(PG8_SA(1, 1), a1 + hstepA, voffA);
            PG8_WAIT_L(8); PG8_BAR; PG8_WAIT_L(0); PG8_MMA(0, 0, At, B0); PG8_BAR; PG8_SCHED;
            PG8_LDB(B1, 0, 1); PG8_STAGE(PG8_SB(0, 0), b2, voffB);
            PG8_BAR; PG8_WAIT_L(0); PG8_MMA(0, 1, At, B1); PG8_BAR;
            PG8_LDA(At, 0, 1); PG8_STAGE(PG8_SA(0, 0), a2, voffA);
            PG8_BAR; PG8_WAIT_L(0); PG8_MMA(1, 0, At, B0); PG8_BAR; PG8_SCHED;
            PG8_STAGE(PG8_SB(0, 1), b2 + hstep, voffB);
            PG8_WAIT_V(6); PG8_BAR; PG8_MMA(1, 1, At, B1); PG8_BAR;
            PG8_LDB(B0, 1, 0); PG8_SCHED; PG8_LDA(At, 1, 0); PG8_STAGE(PG8_SA(0, 1), a2 + hstepA, voffA);
            PG8_WAIT_L(8); PG8_BAR; PG8_WAIT_L(0); PG8_MMA(0, 0, At, B0); PG8_BAR; PG8_SCHED;
            PG8_LDB(B1, 1, 1); PG8_STAGE(PG8_SB(1, 0), b3, voffB);
            PG8_BAR; PG8_WAIT_L(0); PG8_MMA(0, 1, At, B1); PG8_BAR;
            PG8_LDA(At, 1, 1); PG8_STAGE(PG8_SA(1, 0), a3, voffA);
            PG8_BAR; PG8_WAIT_L(0); PG8_MMA(1, 0, At, B0); PG8_BAR; PG8_SCHED;
            PG8_STAGE(PG8_SB(1, 1), b3 + hstep, voffB);
            PG8_WAIT_V(6); PG8_BAR; PG8_MMA(1, 1, At, B1); PG8_BAR;
            }
        }
        if constexpr (ALIGN_EPI) { if (wr == 0) PG8_BAR; }
        if constexpr (!Epi::AFTER_DRAIN) { E(acc, cur, wr, wc, fr, fq); S.done(cur); }
        if (!has_next) break;
#pragma unroll
        for (int a = 0; a < 2; ++a)
#pragma unroll
            for (int b = 0; b < 2; ++b)
#pragma unroll
                for (int m = 0; m < 4; ++m)
#pragma unroll
                    for (int n = 0; n < 2; ++n) acc[a][b][m][n] = (f32x4){0.f, 0.f, 0.f, 0.f};
        cur = nxt; cA = nA; cB = nB; ++ui;
        if constexpr (ALIGN_EPI) { if (wr == 1) PG8_BAR; }
    }
    PG8_WAIT_V(0);
    if constexpr (!ALIGN_EPI) { if (wr == 0) PG8_BAR; }
    PG8_BAR;
    if constexpr (Epi::AFTER_DRAIN) { E.fused(acc, cur, wr, wc, fr, fq, lds, wid, lane); S.done(cur); }
#undef PG8_SA
#undef PG8_SB
#undef PG8_STAGE
#undef PG8_LDA
#undef PG8_LDB
#undef PG8_MMA
#undef PG8_WAIT_V
#undef PG8_WAIT_L
#undef PG8_BAR
#undef PG8_SCHED
}
}

#define LAS __attribute__((address_space(3)))
typedef unsigned short bf16_t;
typedef short bf16x8 __attribute__((ext_vector_type(8)));
typedef float f32x4 __attribute__((ext_vector_type(4)));
typedef float f32x16 __attribute__((ext_vector_type(16)));
typedef unsigned u32x4 __attribute__((ext_vector_type(4)));
typedef unsigned u32x2 __attribute__((ext_vector_type(2)));
using pg8::pk2; using pg8::bflo; using pg8::bfhi; using pg8::fast_sigmoid; using pg8::fast_silu; using pg8::silu4;

constexpr int DM = 1024, SEQ = 2048, NB = 32, DFF = 2816, DINNER = 2048, CONVD = 4096;
constexpr int SB = 8, SSEQ = 16;
constexpr int MP = NB * SEQ;
constexpr int MS = SB * SSEQ;
constexpr int MV = MP + MS;
constexpr int MT = MP + 256;
constexpr int NWIN1 = 6400, NWIN = 9472;
constexpr float EPS = 1e-6f;
constexpr int NTHREADS = 512, NWAVES = 8;
constexpr int LDS_BYTES = 147456;

constexpr size_t O_YP = 0, O_YS = 67108864, O_CONVP = 67239936, O_SSMP = 67633152, O_POOLP = 76021760, O_CONVS = 76513280, O_SSMS = 76611584, O_POOLS = 78708736;

constexpr size_t MiB = 1u << 20;
constexpr size_t WS_WGU1 = 1 * MiB;
constexpr size_t WS_WD1 = WS_WGU1 + (size_t)5632 * 1024 * 2;
constexpr size_t WS_WIN = WS_WD1 + (size_t)1024 * 2816 * 2;
constexpr size_t WS_WPS = WS_WIN + (size_t)NWIN * 1024 * 2;
constexpr size_t WS_WCOMB = WS_WPS + (size_t)1024 * 2048 * 2;
constexpr size_t WS_WOUT = WS_WCOMB + (size_t)1024 * 1024 * 2;
constexpr size_t WS_WGU2 = WS_WOUT + (size_t)1024 * 1024 * 2;
constexpr size_t WS_WD2 = WS_WGU2 + (size_t)5632 * 1024 * 2;
constexpr size_t WS_WEND = WS_WD2 + (size_t)1024 * 2816 * 2;
static_assert(WS_WEND <= 61 * MiB, "weights");
constexpr size_t WS_DT = 61 * MiB;
constexpr size_t WS_RN = 69 * MiB + 512 * 1024;
constexpr size_t WS_XB = 70 * MiB;
constexpr size_t WS_R1 = 199 * MiB;
constexpr size_t WS_R2 = 456 * MiB;
constexpr size_t WS_END = WS_R2 + (size_t)MT * 4096 * 2;
static_assert(WS_DT + (size_t)MT * 32 * 4 <= WS_RN && WS_RN + (size_t)MT * 4 <= WS_XB && WS_XB + (size_t)MT * 1024 * 2 <= WS_R1 && WS_R1 + (size_t)MT * 2048 * 2 <= WS_R2 && WS_END <= 1024 * MiB, "ws map");

__device__ __forceinline__ float wave_sum(float v) {
#pragma unroll
    for (int o = 1; o < 64; o <<= 1) v += __shfl_xor(v, o);
    return v;
}

template <int MODE>
__device__ __forceinline__ void wt_item(const float* W0, const float* W1, int N, int K, const float* kscale, bf16_t* WT, int nblk, LAS float* scr, int item, int lane) {
    const int kb = item / nblk, nb = item % nblk, k0 = 64 * kb, n0 = 32 * nb;
    const int np = n0 + (lane & 31);
    const float* src = W0; int col = np;
    if (MODE == 1) { const int pn = np >> 8, c = np & 255, bj = c >> 7, wc = (c >> 5) & 3, n = (c >> 4) & 1, fq = (c >> 2) & 3, i = c & 3;
        col = 128 * pn + 32 * wc + 8 * fq + 4 * bj + i; src = n ? W1 : W0; }
    if (MODE == 2) { col = np < 6176 ? np : (np < 6400 ? -1 : np - 224); }
    {
        const int n4 = 4 * (lane & 7), npq = n0 + n4;
        const float* srcq = W0; int colq = npq;
        if (MODE == 1) { const int pn = npq >> 8, c = npq & 255, bj = c >> 7, wc = (c >> 5) & 3, n = (c >> 4) & 1, fq = (c >> 2) & 3;
            colq = 128 * pn + 32 * wc + 8 * fq + 4 * bj; srcq = n ? W1 : W0; }
        if (MODE == 2) { colq = npq < 6176 ? npq : (npq < 6400 ? -1 : npq - 224); }
#pragma unroll
        for (int i = 0; i < 8; ++i) { const int kk = 8 * i + (lane >> 3);
            f32x4 v = {0.f, 0.f, 0.f, 0.f};
            if (colq >= 0) { v = *(const f32x4*)(srcq + (size_t)(k0 + kk) * N + colq); if (kscale) v = v * kscale[k0 + kk]; }
            LAS float* d = scr + kk * 33 + n4; d[0] = v[0]; d[1] = v[1]; d[2] = v[2]; d[3] = v[3]; }
    }
    asm volatile("s_waitcnt lgkmcnt(0)" ::: "memory");
    const int c = lane & 7;
#pragma unroll
    for (int j = 0; j < 4; ++j) { const int n = (lane >> 3) + 8 * j; const LAS float* s = scr + (8 * c) * 33 + n;
        u32x4 o; o.x = pk2(s[0 * 33], s[1 * 33]); o.y = pk2(s[2 * 33], s[3 * 33]); o.z = pk2(s[4 * 33], s[5 * 33]); o.w = pk2(s[6 * 33], s[7 * 33]);
        *(u32x4*)(WT + (size_t)(n0 + n) * K + k0 + 8 * c) = o; }
    asm volatile("s_waitcnt lgkmcnt(0)" ::: "memory");
}

__device__ __forceinline__ void wcomb_task(const float* mix, const float* scale, const float* wpp, bf16_t* WC, int task, int lane) {
    const int nb = task & 15, klb = (task >> 4) & 31, g = task >> 9;
    const int n = nb * 64 + lane, kl0 = klb * 8;
    float acc[8];
#pragma unroll
    for (int i = 0; i < 8; ++i) acc[i] = 0.f;
    const float* mrow = mix + ((size_t)g * 256 + kl0) * 256;
    for (int j = 0; j < 256; j += 4) {
        const f32x4 sc4 = *(const f32x4*)(scale + 256 * g + j);
        float w[4];
#pragma unroll
        for (int e = 0; e < 4; ++e) w[e] = sc4[e] * wpp[(size_t)(256 * g + j + e) * 1024 + n];
#pragma unroll
        for (int i = 0; i < 8; ++i) { const f32x4 m4 = *(const f32x4*)(mrow + i * 256 + j);
            acc[i] += (m4[0] * w[0] + m4[1] * w[1]) + (m4[2] * w[2] + m4[3] * w[3]); }
    }
    u32x4 o; o.x = pk2(acc[0], acc[1]); o.y = pk2(acc[2], acc[3]); o.z = pk2(acc[4], acc[5]); o.w = pk2(acc[6], acc[7]);
    *(u32x4*)(WC + (size_t)n * 1024 + 256 * g + kl0) = o;
}

__device__ __forceinline__ void norm_row_to_bf16(const float* xrow, bf16_t* orow, int lane) {
    const f32x4* xr = (const f32x4*)xrow + lane;
    f32x4 v[4]; float s = 0.f;
#pragma unroll
    for (int j = 0; j < 4; ++j) { v[j] = xr[64 * j]; s += (v[j].x * v[j].x + v[j].y * v[j].y) + (v[j].z * v[j].z + v[j].w * v[j].w); }
    const float rstd = rsqrtf(wave_sum(s) * (1.f / DM) + EPS);
    u32x2* o8 = (u32x2*)orow + lane;
#pragma unroll
    for (int j = 0; j < 4; ++j) { u32x2 w; w.x = pk2(v[j].x * rstd, v[j].y * rstd); w.y = pk2(v[j].z * rstd, v[j].w * rstd); o8[64 * j] = w; }
}

__device__ __forceinline__ void post_row(const float* xin, const bf16_t* frow, const float* gpost, float c, float* xout, bf16_t* xb, int lane) {
    const f32x4* xr = (const f32x4*)xin + lane; const u32x2* fr = (const u32x2*)frow + lane; const f32x4* gr = (const f32x4*)gpost + lane;
    f32x4 f[4]; float s = 0.f;
#pragma unroll
    for (int j = 0; j < 4; ++j) { const u32x2 w = fr[64 * j]; f[j] = (f32x4){bflo(w.x), bfhi(w.x), bflo(w.y), bfhi(w.y)}; s += (f[j].x * f[j].x + f[j].y * f[j].y) + (f[j].z * f[j].z + f[j].w * f[j].w); }
    const float rf = c * rsqrtf(wave_sum(s) * (1.f / DM) + EPS);
    f32x4 v[4]; float s2 = 0.f;
#pragma unroll
    for (int j = 0; j < 4; ++j) { v[j] = xr[64 * j] + f[j] * rf * gr[64 * j]; s2 += (v[j].x * v[j].x + v[j].y * v[j].y) + (v[j].z * v[j].z + v[j].w * v[j].w); }
    f32x4* xo = (f32x4*)xout + lane;
#pragma unroll
    for (int j = 0; j < 4; ++j) xo[64 * j] = v[j];
    if (xb) {
        const float rstd = rsqrtf(wave_sum(s2) * (1.f / DM) + EPS);
        u32x2* o8 = (u32x2*)xb + lane;
#pragma unroll
        for (int j = 0; j < 4; ++j) { u32x2 w; w.x = pk2(v[j].x * rstd, v[j].y * rstd); w.y = pk2(v[j].z * rstd, v[j].w * rstd); o8[64 * j] = w; }
    }
}


template <int R>
__device__ __forceinline__ void post_rows(const float* xin, const bf16_t* frow, const float* gpost, float c, float* xout, bf16_t* xb, int lane) {
    f32x4 f[R][4], v[R][4]; float s[R];
#pragma unroll
    for (int r = 0; r < R; ++r) { const u32x2* fr = (const u32x2*)(frow + (size_t)r * DM) + lane; const f32x4* xr = (const f32x4*)(xin + (size_t)r * DM) + lane;
#pragma unroll
        for (int j = 0; j < 4; ++j) { const u32x2 w = fr[64 * j]; f[r][j] = (f32x4){bflo(w.x), bfhi(w.x), bflo(w.y), bfhi(w.y)}; v[r][j] = xr[64 * j]; } }
    f32x4 g[4];
#pragma unroll
    for (int j = 0; j < 4; ++j) g[j] = ((const f32x4*)gpost + lane)[64 * j];
#pragma unroll
    for (int r = 0; r < R; ++r) { s[r] = 0.f;
#pragma unroll
        for (int j = 0; j < 4; ++j) s[r] += (f[r][j].x * f[r][j].x + f[r][j].y * f[r][j].y) + (f[r][j].z * f[r][j].z + f[r][j].w * f[r][j].w); }
#pragma unroll
    for (int o = 1; o < 64; o <<= 1) {
#pragma unroll
        for (int r = 0; r < R; ++r) s[r] += __shfl_xor(s[r], o); }
    float s2[R];
#pragma unroll
    for (int r = 0; r < R; ++r) { const float rf = c * rsqrtf(s[r] * (1.f / DM) + EPS); s2[r] = 0.f; f32x4* xo = (f32x4*)(xout + (size_t)r * DM) + lane;
#pragma unroll
        for (int j = 0; j < 4; ++j) { v[r][j] = v[r][j] + f[r][j] * rf * g[j]; s2[r] += (v[r][j].x * v[r][j].x + v[r][j].y * v[r][j].y) + (v[r][j].z * v[r][j].z + v[r][j].w * v[r][j].w); xo[64 * j] = v[r][j]; } }
    if (xb) {
#pragma unroll
        for (int o = 1; o < 64; o <<= 1) {
#pragma unroll
            for (int r = 0; r < R; ++r) s2[r] += __shfl_xor(s2[r], o); }
#pragma unroll
        for (int r = 0; r < R; ++r) { const float rstd = rsqrtf(s2[r] * (1.f / DM) + EPS); u32x2* o8 = (u32x2*)(xb + (size_t)r * DM) + lane;
#pragma unroll
            for (int j = 0; j < 4; ++j) { u32x2 w; w.x = pk2(v[r][j].x * rstd, v[r][j].y * rstd); w.y = pk2(v[r][j].z * rstd, v[r][j].w * rstd); o8[64 * j] = w; } }
    }
}
template <int R>
__device__ __forceinline__ void norm_rows_to_bf16(const float* xrow, bf16_t* orow, float* rn, int lane) {
    f32x4 v[R][4]; float s[R];
#pragma unroll
    for (int r = 0; r < R; ++r) { const f32x4* xr = (const f32x4*)(xrow + (size_t)r * DM) + lane; s[r] = 0.f;
#pragma unroll
        for (int j = 0; j < 4; ++j) v[r][j] = xr[64 * j]; }
#pragma unroll
    for (int r = 0; r < R; ++r)
#pragma unroll
        for (int j = 0; j < 4; ++j) s[r] += (v[r][j].x * v[r][j].x + v[r][j].y * v[r][j].y) + (v[r][j].z * v[r][j].z + v[r][j].w * v[r][j].w);
#pragma unroll
    for (int o = 1; o < 64; o <<= 1) {
#pragma unroll
        for (int r = 0; r < R; ++r) s[r] += __shfl_xor(s[r], o); }
#pragma unroll
    for (int r = 0; r < R; ++r) { const float ms = s[r] * (1.f / DM) + EPS; const float rstd = rsqrtf(ms); u32x2* o8 = (u32x2*)(orow + (size_t)r * DM) + lane; if (lane == 0) rn[r] = ms * rstd;
#pragma unroll
        for (int j = 0; j < 4; ++j) { u32x2 w; w.x = pk2(v[r][j].x * rstd, v[r][j].y * rstd); w.y = pk2(v[r][j].z * rstd, v[r][j].w * rstd); o8[64 * j] = w; } }
}


template <int R, bool FINAL>
__device__ __forceinline__ void post_rows2(bf16_t* xb, float* rn, const bf16_t* frow, const float* gpost, float c, float* yout, int lane) {
    f32x4 f[R][4], v[R][4]; float s[R], rnv[R];
#pragma unroll
    for (int r = 0; r < R; ++r) { const u32x2* fr = (const u32x2*)(frow + (size_t)r * DM) + lane; const u32x2* xr = (const u32x2*)(xb + (size_t)r * DM) + lane; rnv[r] = rn[r];
#pragma unroll
        for (int j = 0; j < 4; ++j) { const u32x2 w = fr[64 * j]; f[r][j] = (f32x4){bflo(w.x), bfhi(w.x), bflo(w.y), bfhi(w.y)}; const u32x2 x = xr[64 * j]; v[r][j] = (f32x4){bflo(x.x), bfhi(x.x), bflo(x.y), bfhi(x.y)}; } }
    f32x4 g[4];
#pragma unroll
    for (int j = 0; j < 4; ++j) g[j] = ((const f32x4*)gpost + lane)[64 * j];
#pragma unroll
    for (int r = 0; r < R; ++r) { s[r] = 0.f;
#pragma unroll
        for (int j = 0; j < 4; ++j) s[r] += (f[r][j].x * f[r][j].x + f[r][j].y * f[r][j].y) + (f[r][j].z * f[r][j].z + f[r][j].w * f[r][j].w); }
#pragma unroll
    for (int o = 1; o < 64; o <<= 1) {
#pragma unroll
        for (int r = 0; r < R; ++r) s[r] += __shfl_xor(s[r], o); }
    float s2[R];
#pragma unroll
    for (int r = 0; r < R; ++r) { const float rf = c * rsqrtf(s[r] * (1.f / DM) + EPS); s2[r] = 0.f;
#pragma unroll
        for (int j = 0; j < 4; ++j) { v[r][j] = v[r][j] * rnv[r] + f[r][j] * rf * g[j]; s2[r] += (v[r][j].x * v[r][j].x + v[r][j].y * v[r][j].y) + (v[r][j].z * v[r][j].z + v[r][j].w * v[r][j].w); }
        if (FINAL) { f32x4* yo = (f32x4*)(yout + (size_t)r * DM) + lane;
#pragma unroll
            for (int j = 0; j < 4; ++j) yo[64 * j] = v[r][j]; } }
    if (!FINAL) {
#pragma unroll
        for (int o = 1; o < 64; o <<= 1) {
#pragma unroll
            for (int r = 0; r < R; ++r) s2[r] += __shfl_xor(s2[r], o); }
#pragma unroll
        for (int r = 0; r < R; ++r) { const float ms = s2[r] * (1.f / DM) + EPS; const float rstd = rsqrtf(ms); u32x2* o8 = (u32x2*)(xb + (size_t)r * DM) + lane;
#pragma unroll
            for (int j = 0; j < 4; ++j) { u32x2 w; w.x = pk2(v[r][j].x * rstd, v[r][j].y * rstd); w.y = pk2(v[r][j].z * rstd, v[r][j].w * rstd); o8[64 * j] = w; }
            if (lane == 0) rn[r] = ms * rstd; }
    }
}

constexpr int XS_OFF = 0, XS_P = 544;
constexpr int BS_OFF = 34816, RB_P = 288;
constexpr int CS_OFF = 53248;
constexpr int S_OFF = 71680, RC_P = 272;
constexpr int YS_OFF = CS_OFF, YS_P = 528;
constexpr int TAB_OFF = 89088;
constexpr int MF_OFF = 94208;
static_assert(MF_OFF >= TAB_OFF + 4 * 1024 + 64 && MF_OFF + 24576 <= 131072, "ssd lds 2");
static_assert(YS_OFF + 64 * YS_P <= TAB_OFF && S_OFF + 64 * RC_P <= TAB_OFF && TAB_OFF + 4 * 1024 + 64 <= 131072, "ssd lds");
typedef short s16x4 __attribute__((ext_vector_type(4)));
__device__ __forceinline__ bf16x8 tr_frag(const LAS unsigned char* p0, const LAS unsigned char* p1) {
    const s16x4 a = __builtin_amdgcn_ds_read_tr16_b64_v4i16((LAS s16x4*)p0), b = __builtin_amdgcn_ds_read_tr16_b64_v4i16((LAS s16x4*)p1);
    return __builtin_shufflevector(a, b, 0, 1, 2, 3, 4, 5, 6, 7);
}

__device__ __forceinline__ int crow(int reg, int h) { return (reg & 3) + 8 * (reg >> 2) + 4 * h; }
#define MFMA32(a, b, c) __builtin_amdgcn_mfma_f32_32x32x16_bf16((a), (b), (c), 0, 0, 0)

__device__ __forceinline__ void ssd_item(LAS unsigned char* lds, const bf16_t* XBC, bf16_t* ZY, const float* DT, int row0, int T, int g,
                                         const float* h0  , const float* convc  , float* ssm_out  ,
                                         const float* conv_w, const float* conv_b, const float* a_log, const float* d_skip) {
    const int tid = threadIdx.x, lane = tid & 63, wave = __builtin_amdgcn_readfirstlane(tid >> 6);
    const int hh = wave >> 1, ph = wave & 1, half = lane >> 5, r31 = lane & 31;
    const int cq = tid & 127, rq = wave >> 1, lc = 4 * cq;
    const int seg = lc < 256 ? 0 : (lc < 384 ? 1 : 2);
    const int col0 = seg == 0 ? 256 * g + lc : (seg == 1 ? 2048 + 128 * g + (lc - 256) : 3072 + 128 * g + (lc - 384));
    const int pitchA = seg == 0 ? XS_P : RB_P;
    LAS unsigned char* const pRM = lds + (seg == 0 ? XS_OFF + lc * 2 : (seg == 1 ? BS_OFF + (lc - 256) * 2 : CS_OFF + (lc - 384) * 2)) + 16 * rq * pitchA;
    const float a_h = -__expf(a_log[4 * g + hh]);
    const float a_scan = -__expf(a_log[4 * g + (wave & 3)]);
    const float Dh = d_skip[4 * g + hh];
    (void)a_h;
    f32x16 hT[4];
    {
        const float* hb = h0 ? h0 + ((size_t)hh * 64 + 32 * ph + r31) * 128 + 4 * half : nullptr;
#pragma unroll
        for (int nb = 0; nb < 4; ++nb)
#pragma unroll
            for (int q = 0; q < 4; ++q) { f32x4 v = {0.f, 0.f, 0.f, 0.f}; if (hb) v = *(const f32x4*)(hb + 32 * nb + 8 * q);
                hT[nb][4 * q] = v[0]; hT[nb][4 * q + 1] = v[1]; hT[nb][4 * q + 2] = v[2]; hT[nb][4 * q + 3] = v[3]; }
    }
    LAS unsigned char* const pYs = lds + YS_OFF + (4 * half) * YS_P + (64 * hh + 32 * ph + r31) * 2;
    const LAS unsigned char* const pCs = lds + CS_OFF + r31 * RB_P + (4 * half) * 2;
    const int trq = (lane & 15) >> 2, trp = lane & 3, trb = (lane >> 4) & 1;
    const LAS unsigned char* const pXf = lds + XS_OFF + (8 * half + trq) * XS_P + (64 * hh + 32 * ph + 16 * trb + 4 * trp) * 2;
    const LAS unsigned char* const pBt = lds + BS_OFF + (8 * half + trq) * RB_P + (16 * trb + 4 * trp) * 2;
    const LAS unsigned char* const pS = lds + S_OFF + r31 * RC_P + (8 * half) * 4;
    LAS float* dtL = (LAS float*)(lds + TAB_OFF); LAS float* acsL = dtL + 256; LAS float* eacsL = dtL + 512; LAS float* wL = dtL + 768; LAS float* eAL = dtL + 1024;
    const int nch = (T + 63) >> 6;
    for (int c = 0; c < nch; ++c) {
        const int t0 = 64 * c; const int valid = (T - t0) < 64 ? (T - t0) : 64;
        {
            const int rb = 16 * rq;
            u32x2 raw[19];
#pragma unroll
            for (int j = 0; j < 19; ++j) { const int t = t0 + rb - 3 + j;
                raw[j] = (u32x2){0u, 0u};
                if (t >= 0 && t < T) raw[j] = *(const u32x2*)(XBC + (size_t)(row0 + t) * CONVD + col0); }
            f32x4 cw[4];
#pragma unroll
            for (int k = 0; k < 4; ++k) cw[k] = *(const f32x4*)(conv_w + k * CONVD + col0);
            const f32x4 cb = *(const f32x4*)(conv_b + col0);
#pragma unroll
            for (int r = 0; r < 16; r += 2) {
                f32x4 xw5[5];
#pragma unroll
                for (int j = 0; j < 5; ++j) { const int t = t0 + rb - 3 + r + j; const u32x2 w = raw[r + j];
                    xw5[j] = (f32x4){bflo(w.x), bfhi(w.x), bflo(w.y), bfhi(w.y)};
                    if (t < 0 && convc) xw5[j] = *(const f32x4*)(convc + (3 + t) * CONVD + col0); }
                f32x4 o0 = cb + cw[0] * xw5[0] + cw[1] * xw5[1] + cw[2] * xw5[2] + cw[3] * xw5[3];
                f32x4 o1 = cb + cw[0] * xw5[1] + cw[1] * xw5[2] + cw[2] * xw5[3] + cw[3] * xw5[4];
                o0 = silu4(o0); o1 = silu4(o1);
                if (valid < 64) { if (rb + r >= valid) o0 = (f32x4){0.f, 0.f, 0.f, 0.f}; if (rb + r + 1 >= valid) o1 = (f32x4){0.f, 0.f, 0.f, 0.f}; }
                *(LAS u32x2*)(pRM + r * pitchA) = (u32x2){pk2(o0[0], o0[1]), pk2(o0[2], o0[3])}; *(LAS u32x2*)(pRM + (r + 1) * pitchA) = (u32x2){pk2(o1[0], o1[1]), pk2(o1[2], o1[3])};
                __builtin_amdgcn_sched_barrier(0);
            }
        }
        if (wave < 4) {
            const float dtv = lane < valid ? DT[(size_t)(row0 + t0 + lane) * 32 + 4 * g + wave] : 0.f;
            float cs = dtv;
#pragma unroll
            for (int o = 1; o < 64; o <<= 1) { const float t = __shfl_up(cs, o); if (lane >= o) cs += t; }
            const float acs = a_scan * cs; const float tot = __shfl(acs, 63);
            dtL[wave * 64 + lane] = dtv; acsL[wave * 64 + lane] = acs; eacsL[wave * 64 + lane] = __expf(acs); wL[wave * 64 + lane] = dtv * __expf(tot - acs);
            if (lane == 0) eAL[wave] = __expf(tot);
        }
        __syncthreads();
        {
            const int fr = lane & 15, fq = lane >> 4;
#pragma unroll
            for (int tt = 0; tt < 2; ++tt) { const int t = 2 * wave + tt, lt = t >> 2, st = t & 3;
                {
                    f32x4 sacc = {0.f, 0.f, 0.f, 0.f};
#pragma unroll
                    for (int ks = 0; ks < 4; ++ks) {
                        const bf16x8 af = *(const LAS bf16x8*)(lds + CS_OFF + (16 * lt + fr) * RB_P + (32 * ks + 8 * fq) * 2);
                        const bf16x8 bfr = *(const LAS bf16x8*)(lds + BS_OFF + (16 * st + fr) * RB_P + (32 * ks + 8 * fq) * 2);
                        sacc = __builtin_amdgcn_mfma_f32_16x16x32_bf16(af, bfr, sacc, 0, 0, 0);
                    }
#pragma unroll
                    for (int j = 0; j < 4; ++j) *(LAS float*)(lds + S_OFF + (16 * lt + 4 * fq + j) * RC_P + (16 * st + fr) * 4) = sacc[j];
                }
            }
        }
        __syncthreads();
#pragma unroll 1
        for (int it3 = 0; it3 < 3; ++it3) {
            const int fi = ph + 2 * it3;
            const int lt = fi >= 2 ? 1 : 0, ks = lt ? fi - 2 : fi;
            const int l = 32 * lt + r31; const float acs_l = acsL[hh * 64 + l];
            const int s0 = 16 * ks + 8 * half;
            const LAS float* sp = (const LAS float*)(pS + (32 * lt) * RC_P + (16 * ks) * 4);
            const f32x4 sv0 = *(const LAS f32x4*)sp, sv1 = *(const LAS f32x4*)(sp + 4);
            const f32x4 as0 = *(const LAS f32x4*)(acsL + hh * 64 + s0), as1 = *(const LAS f32x4*)(acsL + hh * 64 + s0 + 4);
            const f32x4 d0 = *(const LAS f32x4*)(dtL + hh * 64 + s0), d1 = *(const LAS f32x4*)(dtL + hh * 64 + s0 + 4);
            float mv[8];
            if (lt == 1 && ks < 2) {
#pragma unroll
                for (int j = 0; j < 8; ++j) { const float sv = j < 4 ? sv0[j & 3] : sv1[j & 3], as = j < 4 ? as0[j & 3] : as1[j & 3], dd = j < 4 ? d0[j & 3] : d1[j & 3];
                    mv[j] = sv * __expf(acs_l - as) * dd; }
            } else {
                const float dl0 = (float)(l - s0);
#pragma unroll
                for (int j = 0; j < 8; ++j) { const float sv = j < 4 ? sv0[j & 3] : sv1[j & 3], as = j < 4 ? as0[j & 3] : as1[j & 3], dd = j < 4 ? d0[j & 3] : d1[j & 3];
                    const float dl = dl0 - (float)j;
                    const float maskf = fminf(fmaxf(dl + 1.f, 0.f), 1.f);
                    const float diagf = fmaxf(1.f - fabsf(dl), 0.f);
                    mv[j] = sv * __expf(fminf(acs_l - as, 0.f)) * dd * maskf + Dh * diagf; }
            }
            u32x4 ap; ap.x = pk2(mv[0], mv[1]); ap.y = pk2(mv[2], mv[3]); ap.z = pk2(mv[4], mv[5]); ap.w = pk2(mv[6], mv[7]);
            *(LAS u32x4*)(lds + MF_OFF + ((hh * 6 + fi) * 64 + lane) * 16) = ap;
        }
        f32x16 y[2];
#pragma unroll
        for (int lt = 0; lt < 2; ++lt)
#pragma unroll
            for (int i = 0; i < 16; ++i) y[lt][i] = 0.f;
#pragma unroll
        for (int nb = 0; nb < 4; ++nb)
#pragma unroll
            for (int s = 0; s < 2; ++s) {
                u32x4 bp; bp.x = pk2(hT[nb][8 * s + 0], hT[nb][8 * s + 1]); bp.y = pk2(hT[nb][8 * s + 2], hT[nb][8 * s + 3]); bp.z = pk2(hT[nb][8 * s + 4], hT[nb][8 * s + 5]); bp.w = pk2(hT[nb][8 * s + 6], hT[nb][8 * s + 7]);
                const bf16x8 bfrag = __builtin_bit_cast(bf16x8, bp);
#pragma unroll
                for (int lt = 0; lt < 2; ++lt) {
                    const LAS unsigned char* cp = pCs + (32 * lt) * RB_P + (32 * nb + 16 * s) * 2;
                    const u32x2 lo = *(const LAS u32x2*)cp, hi = *(const LAS u32x2*)(cp + 16);
                    const bf16x8 afrag = __builtin_bit_cast(bf16x8, (u32x4){lo.x, lo.y, hi.x, hi.y});
                    y[lt] = MFMA32(afrag, bfrag, y[lt]);
                }
                __builtin_amdgcn_sched_barrier(0);
            }
#pragma unroll
        for (int lt = 0; lt < 2; ++lt)
#pragma unroll
            for (int q = 0; q < 4; ++q) { const f32x4 e = *(const LAS f32x4*)(eacsL + hh * 64 + 32 * lt + 8 * q + 4 * half);
#pragma unroll
                for (int j = 0; j < 4; ++j) y[lt][4 * q + j] *= e[j]; }
        bf16x8 xf[4];
#pragma unroll
        for (int ks = 0; ks < 4; ++ks) xf[ks] = tr_frag(pXf + (16 * ks) * XS_P, pXf + (16 * ks + 4) * XS_P);
        __syncthreads();
#pragma unroll
        for (int fi = 0; fi < 6; ++fi) { const int lt = fi >= 2 ? 1 : 0, ks = lt ? fi - 2 : fi;
            const bf16x8 mf = *(const LAS bf16x8*)(lds + MF_OFF + ((hh * 6 + fi) * 64 + lane) * 16);
            y[lt] = MFMA32(mf, xf[ks], y[lt]); }
        __syncthreads();
#pragma unroll
        for (int lt = 0; lt < 2; ++lt)
#pragma unroll
            for (int i = 0; i < 16; ++i)
                *(LAS bf16_t*)(pYs + (32 * lt + (i & 3) + 8 * (i >> 2)) * YS_P) = (bf16_t)(pk2(y[lt][i], 0.f) & 0xffffu);
        const int nl = tid >> 3, npart = tid & 7;
        u32x4 zr[4];
        {
            const bf16_t* zp = ZY + (size_t)(row0 + t0 + (nl < valid ? nl : 0)) * DINNER + 256 * g + 32 * npart;
#pragma unroll
            for (int q = 0; q < 4; ++q) zr[q] = *(const u32x4*)(zp + 8 * q);
        }
        {
            const float eA = eAL[hh];
#pragma unroll
            for (int nb = 0; nb < 4; ++nb)
#pragma unroll
                for (int i = 0; i < 16; ++i) hT[nb][i] *= eA;
            bf16x8 xw[4];
#pragma unroll
            for (int ks = 0; ks < 4; ++ks) { const u32x4 xr = __builtin_bit_cast(u32x4, xf[ks]);
                const f32x4 w0 = *(const LAS f32x4*)(wL + hh * 64 + 16 * ks + 8 * half), w1 = *(const LAS f32x4*)(wL + hh * 64 + 16 * ks + 8 * half + 4);
                u32x4 o; o.x = pk2(bflo(xr.x) * w0[0], bfhi(xr.x) * w0[1]); o.y = pk2(bflo(xr.y) * w0[2], bfhi(xr.y) * w0[3]); o.z = pk2(bflo(xr.z) * w1[0], bfhi(xr.z) * w1[1]); o.w = pk2(bflo(xr.w) * w1[2], bfhi(xr.w) * w1[3]);
                xw[ks] = __builtin_bit_cast(bf16x8, o); }
#pragma unroll
            for (int nb = 0; nb < 4; ++nb)
#pragma unroll
                for (int ks = 0; ks < 4; ++ks) {
                    const bf16x8 af = tr_frag(pBt + (16 * ks) * RB_P + 64 * nb, pBt + (16 * ks + 4) * RB_P + 64 * nb);
                    hT[nb] = MFMA32(af, xw[ks], hT[nb]);
                }
        }
        __syncthreads();
        {
            float gv[32]; float ss = 0.f;
#pragma unroll
            for (int q = 0; q < 4; ++q) { const u32x4 yv = *(const LAS u32x4*)(lds + YS_OFF + nl * YS_P + npart * 64 + q * 16);
                const f32x4 za = {bflo(zr[q].x), bfhi(zr[q].x), bflo(zr[q].y), bfhi(zr[q].y)}, zb = {bflo(zr[q].z), bfhi(zr[q].z), bflo(zr[q].w), bfhi(zr[q].w)};
                const f32x4 ya = {bflo(yv.x), bfhi(yv.x), bflo(yv.y), bfhi(yv.y)}, yb = {bflo(yv.z), bfhi(yv.z), bflo(yv.w), bfhi(yv.w)};
                const f32x4 ga = ya * pg8::silu4(za), gb = yb * pg8::silu4(zb);
#pragma unroll
                for (int e = 0; e < 4; ++e) { gv[8 * q + e] = ga[e]; gv[8 * q + 4 + e] = gb[e]; ss += ga[e] * ga[e] + gb[e] * gb[e]; } }
            ss += __shfl_xor(ss, 1); ss += __shfl_xor(ss, 2); ss += __shfl_xor(ss, 4);
            const float rstd = rsqrtf(ss * (1.f / 256.f) + EPS);
            if (nl < valid) {
                bf16_t* op = ZY + (size_t)(row0 + t0 + nl) * DINNER + 256 * g + 32 * npart;
#pragma unroll
                for (int q = 0; q < 4; ++q) { u32x4 o; o.x = pk2(gv[8 * q] * rstd, gv[8 * q + 1] * rstd); o.y = pk2(gv[8 * q + 2] * rstd, gv[8 * q + 3] * rstd); o.z = pk2(gv[8 * q + 4] * rstd, gv[8 * q + 5] * rstd); o.w = pk2(gv[8 * q + 6] * rstd, gv[8 * q + 7] * rstd);
                    *(u32x4*)(op + 8 * q) = o; }
            }
        }
        __syncthreads();
    }
    {
        float* sb = ssm_out + ((size_t)hh * 64 + 32 * ph + r31) * 128 + 4 * half;
#pragma unroll
        for (int nb = 0; nb < 4; ++nb)
#pragma unroll
            for (int q = 0; q < 4; ++q) *(f32x4*)(sb + 32 * nb + 8 * q) = (f32x4){hT[nb][4 * q], hT[nb][4 * q + 1], hT[nb][4 * q + 2], hT[nb][4 * q + 3]};
    }
}

__device__ __forceinline__ void load8(const bf16_t* p, float (&v)[8]) { const u32x4 w = *(const u32x4*)p; v[0] = bflo(w.x); v[1] = bfhi(w.x); v[2] = bflo(w.y); v[3] = bfhi(w.y); v[4] = bflo(w.z); v[5] = bfhi(w.z); v[6] = bflo(w.w); v[7] = bfhi(w.w); }
__device__ __forceinline__ void pool_task(const bf16_t* U, bf16_t* PL, int row0, int T, int t0, int hsel, int pos0, const float* cache  , int lane) {
    const int o = hsel * 64 + lane, col = 8 * o, gi = o >> 5, k = 2 << gi;
    float ws[8];
#pragma unroll
    for (int i = 0; i < 8; ++i) ws[i] = 0.f;
    for (int j = 1; j < k; ++j) { const int t = t0 - j; float v[8];
        if (t >= 0) { load8(U + (size_t)(row0 + t) * DM + col, v); }
        else if (cache) { const f32x4 a = *(const f32x4*)(cache + (15 + t) * DM + col), b = *(const f32x4*)(cache + (15 + t) * DM + col + 4); v[0] = a[0]; v[1] = a[1]; v[2] = a[2]; v[3] = a[3]; v[4] = b[0]; v[5] = b[1]; v[6] = b[2]; v[7] = b[3]; }
        else {
#pragma unroll
            for (int i = 0; i < 8; ++i) v[i] = 0.f; }
#pragma unroll
        for (int i = 0; i < 8; ++i) ws[i] += v[i]; }
    const int nr = (T - t0) < 64 ? (T - t0) : 64;
    for (int r0 = 0; r0 < nr; r0 += 8) {
        u32x4 cu[8], ol[8];
#pragma unroll
        for (int r = 0; r < 8; ++r) { const int t = t0 + r0 + r, to = t - k + 1;
            cu[r] = *(const u32x4*)(U + (size_t)(row0 + t) * DM + col);
            ol[r] = (u32x4){0u, 0u, 0u, 0u};
            if (to >= 0) ol[r] = *(const u32x4*)(U + (size_t)(row0 + to) * DM + col); }
#pragma unroll
        for (int r = 0; r < 8; ++r) { const int t = t0 + r0 + r, to = t - k + 1;
            float cur[8] = {bflo(cu[r].x), bfhi(cu[r].x), bflo(cu[r].y), bfhi(cu[r].y), bflo(cu[r].z), bfhi(cu[r].z), bflo(cu[r].w), bfhi(cu[r].w)};
            float old[8] = {bflo(ol[r].x), bfhi(ol[r].x), bflo(ol[r].y), bfhi(ol[r].y), bflo(ol[r].z), bfhi(ol[r].z), bflo(ol[r].w), bfhi(ol[r].w)};
            if (to < 0 && cache) { const f32x4 a = *(const f32x4*)(cache + (15 + to) * DM + col), b = *(const f32x4*)(cache + (15 + to) * DM + col + 4); old[0] = a[0]; old[1] = a[1]; old[2] = a[2]; old[3] = a[3]; old[4] = b[0]; old[5] = b[1]; old[6] = b[2]; old[7] = b[3]; }
            const int pc = pos0 + t + 1; const float inv = 1.0f / (float)(pc < k ? pc : k);
            float pv[8];
#pragma unroll
            for (int i = 0; i < 8; ++i) { ws[i] += cur[i]; pv[i] = ws[i] * inv - cur[i]; ws[i] -= old[i]; }
            u32x4 w; w.x = pk2(pv[0], pv[1]); w.y = pk2(pv[2], pv[3]); w.z = pk2(pv[4], pv[5]); w.w = pk2(pv[6], pv[7]);
            *(u32x4*)(PL + (size_t)(row0 + t) * DM + col) = w; }
    }
}

enum { SM_SWIGLU = 0, SM_BF16 = 1, SM_WIN1 = 2, SM_WIN2 = 3, SM_GATE0 = 4, SM_GATE1 = 5 };
constexpr int SMR_P = 36, SMT_OFF = 8 * 32 * SMR_P * 4, SMT_P = 33;
template <int MODE>
__device__ __forceinline__ void small_gemm(LAS unsigned char* lds, const bf16_t* A, const bf16_t* Bt, int N, int K,
                                           bf16_t* O0, bf16_t* O1, float* OF, const float* bias) {
    int tid_ = threadIdx.x; asm volatile("" : "+v"(tid_));
    const int tid = tid_, lane = tid & 63, wave = __builtin_amdgcn_readfirstlane(tid >> 6), r31 = lane & 31, half = lane >> 5;
    const int ntiles = 4 * (N >> 5), ksl = K >> 3, nsteps = ksl >> 4;
    LAS float* red = (LAS float*)lds; LAS float* tile = (LAS float*)(lds + SMT_OFF);
    for (int t = blockIdx.x; t < ntiles; t += gridDim.x) {
        const int mq = t & 3, n0 = (t >> 2) << 5;
        const bf16_t* bp = Bt + (size_t)(n0 + r31) * K + wave * ksl + 8 * half;
        const bf16_t* ap = A + (size_t)(32 * mq + r31) * K + wave * ksl + 8 * half;
        f32x16 acc;
#pragma unroll
        for (int i = 0; i < 16; ++i) acc[i] = 0.f;
#pragma unroll 8
        for (int s = 0; s < nsteps; ++s) {
            const bf16x8 bfr = *(const bf16x8*)(bp + 16 * s), afr = *(const bf16x8*)(ap + 16 * s);
            acc = MFMA32(bfr, afr, acc);
        }
#pragma unroll
        for (int q = 0; q < 4; ++q) *(LAS f32x4*)(red + (wave * 32 + r31) * SMR_P + 8 * q + 4 * half) = (f32x4){acc[4 * q], acc[4 * q + 1], acc[4 * q + 2], acc[4 * q + 3]};
        __syncthreads();
        { const int m = tid >> 4, n = 2 * (tid & 15); float s0 = 0.f, s1 = 0.f;
#pragma unroll
          for (int w = 0; w < 8; ++w) { s0 += red[(w * 32 + m) * SMR_P + n]; s1 += red[(w * 32 + m) * SMR_P + n + 1]; }
          tile[m * SMT_P + n] = s0; tile[m * SMT_P + n + 1] = s1; }
        __syncthreads();
        {
            const int m = tid >> 4, j = tid & 15, n = 2 * j; const size_t row = (size_t)MP + 32 * mq + m;
            if (MODE == SM_SWIGLU) {
                const int pn = n0 >> 8, c0 = n0 & 255, bj = c0 >> 7, wc = (c0 >> 5) & 3;
                const int h = 128 * pn + 32 * wc + 8 * (j >> 2) + 4 * bj + (j & 3);
                const float g = tile[m * SMT_P + j], u = tile[m * SMT_P + 16 + j];
                O0[row * DFF + h] = (bf16_t)(pk2(fast_silu(g) * u, 0.f) & 0xffffu);
            } else {
                float v0 = tile[m * SMT_P + n], v1 = tile[m * SMT_P + n + 1]; const int np = n0 + n;
                if (MODE == SM_BF16) { *(unsigned*)(O0 + row * DM + np) = pk2(v0, v1); }
                if (MODE == SM_WIN1) {
                    if (np < 2048) *(unsigned*)(O0 + row * 2048 + np) = pk2(v0, v1);
                    else if (np < 6144) *(unsigned*)(O1 + row * 4096 + (np - 2048)) = pk2(v0, v1);
                    else { const int c = np - 6144; v0 += bias[c]; v1 += bias[c + 1];
                        OF[row * 32 + c] = fmaxf(v0, 0.f) + log1pf(expf(-fabsf(v0))); OF[row * 32 + c + 1] = fmaxf(v1, 0.f) + log1pf(expf(-fabsf(v1))); }
                }
                if (MODE == SM_WIN2) { const int tt = np >> 10; if (tt) { v0 = fast_sigmoid(v0); v1 = fast_sigmoid(v1); }
                    *(unsigned*)(O0 + (size_t)tt * MT * 1024 + row * DM + (np & 1023)) = pk2(v0, v1); }
                if (MODE == SM_GATE0) { unsigned* p = (unsigned*)(O0 + row * DM + np); const unsigned g = *p; *p = pk2(bflo(g) * v0, bfhi(g) * v1); }
                if (MODE == SM_GATE1) { unsigned* p = (unsigned*)(O0 + row * DM + np); const unsigned g = *p, tt = *(const unsigned*)(O1 + row * DM + np);
                    *p = pk2(bflo(tt) + bflo(g) * v0, bfhi(tt) + bfhi(g) * v1); }
            }
        }
    }
    __syncthreads();
}


constexpr int SM16_P = 20;
template <int MODE>
__device__ __forceinline__ void small_gemm16(LAS unsigned char* lds, const bf16_t* A, const bf16_t* Bt, int K, bf16_t* O0, const bf16_t* O1) {
    int tid_ = threadIdx.x; asm volatile("" : "+v"(tid_));
    const int tid = tid_, lane = tid & 63, wave = __builtin_amdgcn_readfirstlane(tid >> 6), r15 = lane & 15, kq = lane >> 4;
    const int ksl = K >> 3, nsteps = ksl >> 5;
    LAS float* red = (LAS float*)lds;
    for (int t = blockIdx.x; t < 256; t += gridDim.x) {
        const int mq = t & 3, n0 = (t >> 2) << 4;
        const bf16_t* bp = Bt + (size_t)(n0 + r15) * K + wave * ksl + 8 * kq;
        const bf16_t* ap = A + (size_t)(32 * mq + r15) * K + wave * ksl + 8 * kq;
        f32x4 acc0 = {0.f, 0.f, 0.f, 0.f}, acc1 = {0.f, 0.f, 0.f, 0.f};
#pragma unroll 4
        for (int s = 0; s < nsteps; ++s) {
            const bf16x8 bfr = *(const bf16x8*)(bp + 32 * s), a0 = *(const bf16x8*)(ap + 32 * s), a1 = *(const bf16x8*)(ap + (size_t)16 * K + 32 * s);
            acc0 = __builtin_amdgcn_mfma_f32_16x16x32_bf16(bfr, a0, acc0, 0, 0, 0);
            acc1 = __builtin_amdgcn_mfma_f32_16x16x32_bf16(bfr, a1, acc1, 0, 0, 0);
        }
        *(LAS f32x4*)(red + (wave * 32 + r15) * SM16_P + 4 * kq) = acc0;
        *(LAS f32x4*)(red + (wave * 32 + 16 + r15) * SM16_P + 4 * kq) = acc1;
        __syncthreads();
        {
            const int m = tid >> 4, n = tid & 15; float v = 0.f;
#pragma unroll
            for (int w = 0; w < 8; ++w) v += red[(w * 32 + m) * SM16_P + n];
            const size_t idx = ((size_t)MP + 32 * mq + m) * DM + n0 + n;
            if (MODE == SM_BF16) O0[idx] = (bf16_t)(pk2(v, 0.f) & 0xffffu);
            if (MODE == SM_GATE0) O0[idx] = (bf16_t)(pk2(bflo((unsigned)O0[idx]) * v, 0.f) & 0xffffu);
            if (MODE == SM_GATE1) O0[idx] = (bf16_t)(pk2(bflo((unsigned)O1[idx]) + bflo((unsigned)O0[idx]) * v, 0.f) & 0xffffu);
        }
        __syncthreads();
    }
}

#define RLX_AGENT __ATOMIC_RELAXED, __HIP_MEMORY_SCOPE_AGENT
#define XB_TMO      128
#define XB_XCNT(j)  (256  + 64 * (j))
#define XB_XSUB(j)  (1280 + 64 * (j))
#define XB_XGEN(j)  (2304 + 64 * (j))
#define XB_TOP      3328
#define XB_TOPGEN   3392
#define XCD_BAR_WORDS 3456
#define XB_SPIN_CAP (1u << 18)

__device__ __forceinline__ unsigned xb_ld(unsigned* p)              { return __hip_atomic_load(p, __ATOMIC_RELAXED, __HIP_MEMORY_SCOPE_AGENT); }
__device__ __forceinline__ unsigned xb_add(unsigned* p, unsigned v) { return __hip_atomic_fetch_add(p, v, __ATOMIC_RELAXED, __HIP_MEMORY_SCOPE_AGENT); }
__device__ __forceinline__ unsigned xb_xcc_id() { return (unsigned)__builtin_amdgcn_s_getreg((3 << 11) | 20) & 0xFu; }
#define XB_SPIN(cond, bar) do { unsigned _sp = 0; while (cond) { __builtin_amdgcn_s_sleep(1); \
    if ((++_sp & 255u) == 0u) { if (xb_ld(&(bar)[XB_TMO])) break; if (_sp > XB_SPIN_CAP) { atomicAdd(&(bar)[XB_TMO], 1u); break; } } } } while (0)

struct XcdBarrier {
    unsigned* bar; unsigned x;
    volatile LAS unsigned* st;
};

__device__ __forceinline__ XcdBarrier xcd_barrier_post(unsigned* bar, volatile LAS unsigned* st) {
    XcdBarrier b; b.bar = bar; b.x = xb_xcc_id(); b.st = st;
    if (threadIdx.x == 0) (void)xb_add(&bar[XB_XCNT(b.x)], 1u);
    return b;
}
__device__ __forceinline__ void xcd_barrier_complete(unsigned* bar, unsigned x, unsigned& nloc, unsigned& nx) {
    const unsigned G = gridDim.x * gridDim.y * gridDim.z;
    unsigned sum, cnt, mine, sp = 0u;
    for (;;) {
        sum = 0u; cnt = 0u; mine = 0u;
#pragma unroll
        for (unsigned j = 0; j < 16; ++j) { const unsigned c = xb_ld(&bar[XB_XCNT(j)]); sum += c; cnt += (c > 0u) ? 1u : 0u; mine = (j == x) ? c : mine; }
        if (sum == G) break;
        __builtin_amdgcn_s_sleep(1);
        if ((++sp & 255u) == 0u) { if (xb_ld(&bar[XB_TMO])) break; if (sp > XB_SPIN_CAP) { atomicAdd(&bar[XB_TMO], 1u); break; } }
    }
    nloc = mine > 0u ? mine : 1u; nx = cnt > 0u ? cnt : 1u;
}

__device__ __forceinline__ void xcd_barrier(const XcdBarrier& b) {
    asm volatile("s_waitcnt vmcnt(0)" ::: "memory");
    __syncthreads();
    if (threadIdx.x == 0) {
        unsigned* bar = b.bar;
        __builtin_amdgcn_s_waitcnt(0);
        unsigned nloc = b.st[0], nx = b.st[1];
        if (nloc == 0u) { xcd_barrier_complete(bar, b.x, nloc, nx); b.st[0] = nloc; b.st[1] = nx; }
        const unsigned old = xb_add(&bar[XB_XSUB(b.x)], 1u);
        const unsigned gen = old / nloc;
        if (old + 1u == (gen + 1u) * nloc) {
            __builtin_amdgcn_fence(__ATOMIC_RELEASE, "agent");
            asm volatile("s_waitcnt vmcnt(0)" ::: "memory");
            const unsigned og = xb_add(&bar[XB_TOP], 1u);
            const unsigned tg = og / nx;
            if (og + 1u == (tg + 1u) * nx) xb_add(&bar[XB_TOPGEN], 1u);
            else XB_SPIN(xb_ld(&bar[XB_TOPGEN]) == tg, bar);
            __builtin_amdgcn_fence(__ATOMIC_ACQUIRE, "agent");
            xb_add(&bar[XB_XGEN(b.x)], 1u);
            asm volatile("s_waitcnt vmcnt(0)" ::: "memory");
        } else {
            XB_SPIN(xb_ld(&bar[XB_XGEN(b.x)]) == gen, bar);
            __builtin_amdgcn_fence(__ATOMIC_ACQUIRE, "agent");
            asm volatile("s_waitcnt vmcnt(0)" ::: "memory");
        }
    }
    __syncthreads();
}

struct Params { const float* in[29]; float* out; unsigned char* ws; };
#define KAS __attribute__((address_space(4)))
__device__ __forceinline__ const KAS unsigned char* kargs() { const KAS unsigned char* p = (const KAS unsigned char*)__builtin_amdgcn_kernarg_segment_ptr(); asm volatile("" : "+s"(p)); return p; }
#define KIN(i) (*(const float* const KAS*)(kargs() + 8 * (i)))
#define KOUT (*(float* const KAS*)(kargs() + 232))
#define KWS (*(unsigned char* const KAS*)(kargs() + 240))
#define WSP(off) ((bf16_t*)(KWS + (off)))
constexpr int XB_ST_OFF = 131072 + 320;
#define XBAR_POST() do { (void)xcd_barrier_post((unsigned*)KWS, (volatile LAS unsigned*)(lds + XB_ST_OFF)); } while (0)
#define XBAR() do { XcdBarrier b_; b_.bar = (unsigned*)KWS; b_.x = xb_xcc_id(); b_.st = (volatile LAS unsigned*)(lds + XB_ST_OFF); xcd_barrier(b_); } while (0)

__global__ void __launch_bounds__(NTHREADS, 2) hybrid_fwd(Params Pdummy) {
    extern __shared__ __attribute__((aligned(16))) unsigned char lds_raw[];
    LAS unsigned char* lds = (LAS unsigned char*)lds_raw;
    cg::grid_group grid = cg::this_grid();
#define TID ((int)threadIdx.x)
#define LANE (TID & 63)
#define WAVE (__builtin_amdgcn_readfirstlane(TID >> 6))
#define GW ((int)blockIdx.x * NWAVES + WAVE)
#define NGW ((int)gridDim.x * NWAVES)
    constexpr size_t R2S = (size_t)MT * 1024 * 2;

    if (TID < 2) ((volatile LAS unsigned*)(lds + XB_ST_OFF))[TID] = 0u;
    if (blockIdx.x == 0) { unsigned* bw = (unsigned*)KWS; for (int i = TID; i < XCD_BAR_WORDS; i += NTHREADS) bw[i] = 0u; }
    {
        const int lane = LANE, wave = WAVE, gw = GW, ngw = NGW;
        LAS float* scr = (LAS float*)(lds + wave * 8448);
        constexpr int I_GU = 16 * 176, I_D = 44 * 32, I_IN = 16 * 296, I_PS = 32 * 32, I_O = 16 * 32;
        constexpr int NITEMS = 2 * (I_GU + I_D) + I_IN + I_PS + I_O;
        for (int it = gw; it < NITEMS; it += ngw) {
            int r = it;
            if (r < I_GU) { wt_item<1>(KIN(7), KIN(8), DFF, DM, KIN(5), WSP(WS_WGU1), 176, scr, r, lane); continue; } r -= I_GU;
            if (r < I_D) { wt_item<0>(KIN(9), nullptr, DM, DFF, nullptr, WSP(WS_WD1), 32, scr, r, lane); continue; } r -= I_D;
            if (r < I_IN) { wt_item<2>(KIN(12), nullptr, 9248, DM, KIN(10), WSP(WS_WIN), 296, scr, r, lane); continue; } r -= I_IN;
            if (r < I_PS) { wt_item<0>(KIN(19), nullptr, DM, DINNER, KIN(18), WSP(WS_WPS), 32, scr, r, lane); continue; } r -= I_PS;
            if (r < I_O) { wt_item<0>(KIN(23), nullptr, DM, DM, nullptr, WSP(WS_WOUT), 32, scr, r, lane); continue; } r -= I_O;
            if (r < I_GU) { wt_item<1>(KIN(26), KIN(27), DFF, DM, KIN(24), WSP(WS_WGU2), 176, scr, r, lane); continue; } r -= I_GU;
            wt_item<0>(KIN(28), nullptr, DM, DFF, nullptr, WSP(WS_WD2), 32, scr, r, lane);
        }
        { const float* mix = KIN(20); const float* sc = KIN(21); const float* wpp = KIN(22); bf16_t* wc = WSP(WS_WCOMB);
          for (int t = gw; t < 2048; t += ngw) wcomb_task(mix, sc, wpp, wc, t, lane); }
        { const float* xp = KIN(0); const float* xs = KIN(1); bf16_t* XB = WSP(WS_XB);
          for (int m = 4 * gw; m < MV; m += 4 * ngw) norm_rows_to_bf16<4>(m < MP ? xp + (size_t)m * DM : xs + (size_t)(m - MP) * DM, XB + (size_t)m * DM, (float*)(KWS + WS_RN) + m, lane); }
    }
    grid.sync();
    XBAR_POST();
    small_gemm<SM_SWIGLU>(lds, WSP(WS_XB) + (size_t)MP * DM, WSP(WS_WGU1), 2 * DFF, DM, WSP(WS_R2), nullptr, nullptr, nullptr);
    { pg8::Gemm g{WSP(WS_XB), WSP(WS_WGU1), MP, 2 * DFF, DM}; pg8::StaticOrder S; S.init(MP, 2 * DFF, gridDim.x, blockIdx.x); pg8::EpiSwiglu E{WSP(WS_R2), DFF};
      pg8::gemm_phase<pg8::EpiSwiglu, pg8::StaticOrder, true, true>(lds, g, S, E); }
    XBAR();
    small_gemm16<SM_BF16>(lds, WSP(WS_R2) + (size_t)MP * DFF, WSP(WS_WD1), DFF, WSP(WS_R1), nullptr);
    { pg8::Gemm g{WSP(WS_R2), WSP(WS_WD1), MP, DM, DFF, 1}; pg8::StaticOrder S; S.init(MP, DM, gridDim.x, blockIdx.x); pg8::EpiBf16 E{WSP(WS_R1), DM};
      pg8::gemm_phase<pg8::EpiBf16, pg8::StaticOrder, true, true>(lds, g, S, E); }
    XBAR();
    { const int lane = LANE, gw = GW, ngw = NGW; const float* gp = KIN(6); const bf16_t* F = WSP(WS_R1); bf16_t* XB = WSP(WS_XB); float* RN = (float*)(KWS + WS_RN);
      for (int m = 4 * gw; m < MV; m += 4 * ngw) post_rows2<4, false>(XB + (size_t)m * DM, RN + m, F + (size_t)m * DM, gp, 0.5f, nullptr, lane); }
    XBAR();
    small_gemm<SM_WIN1>(lds, WSP(WS_XB) + (size_t)MP * DM, WSP(WS_WIN), 6176, DM, WSP(WS_R1), WSP(WS_R2), (float*)(KWS + WS_DT), KIN(15));
    { pg8::Gemm g{WSP(WS_XB), WSP(WS_WIN), MP, NWIN1, DM}; pg8::StaticOrder S; S.init(MP, NWIN1, gridDim.x, blockIdx.x); pg8::EpiWin1 E{WSP(WS_R1), WSP(WS_R2), (float*)(KWS + WS_DT), KIN(15)};
      pg8::gemm_phase<pg8::EpiWin1, pg8::StaticOrder, true, true>(lds, g, S, E); }
    XBAR();
    {
        const int G = gridDim.x, bid = blockIdx.x;
        const bf16_t* XBC = WSP(WS_R2); bf16_t* ZY = WSP(WS_R1); const float* DT = (const float*)(KWS + WS_DT); float* out = KOUT;
        for (int it = bid; it < 256 + 64; it += G) {
            const bool smp = it >= 256; const int b = (smp ? it - 256 : it) >> 3, g = it & 7;
            const float* h0 = smp ? KIN(3) + ((size_t)b * 32 + 4 * g) * 8192 : nullptr;
            const float* cc = smp ? KIN(2) + (size_t)b * 3 * CONVD : nullptr;
            float* so = out + (smp ? O_SSMS : O_SSMP) + ((size_t)b * 32 + 4 * g) * 8192;
            ssd_item(lds, XBC, ZY, DT, smp ? MP + b * SSEQ : b * SEQ, smp ? SSEQ : SEQ, g, h0, cc, so, KIN(13), KIN(14), KIN(16), KIN(17));
        }
        for (int i = bid * NTHREADS + TID; i < 40 * 3 * 1024; i += G * NTHREADS) {
            const int c4 = i & 1023, r = (i >> 10) % 3, s = i / 3072;
            const int row = s < 32 ? s * SEQ + SEQ - 3 + r : MP + (s - 32) * SSEQ + SSEQ - 3 + r;
            const u32x2 w = *(const u32x2*)(XBC + (size_t)row * CONVD + 4 * c4);
            float* dst = s < 32 ? out + O_CONVP + ((size_t)s * 3 + r) * CONVD + 4 * c4 : out + O_CONVS + ((size_t)(s - 32) * 3 + r) * CONVD + 4 * c4;
            *(f32x4*)dst = (f32x4){bflo(w.x), bfhi(w.x), bflo(w.y), bfhi(w.y)};
        }
    }
    XBAR();
    small_gemm<SM_WIN2>(lds, WSP(WS_XB) + (size_t)MP * DM, WSP(WS_WIN + (size_t)NWIN1 * DM * 2), 3072, DM, WSP(WS_R2), nullptr, nullptr, nullptr);
    { pg8::Gemm g{WSP(WS_XB), WSP(WS_WIN + (size_t)NWIN1 * DM * 2), MP, 3072, DM}; pg8::StaticOrder S; S.init(MP, 3072, gridDim.x, blockIdx.x); pg8::EpiWin2 E{WSP(WS_R2), (size_t)MT * 1024};
      pg8::gemm_phase<pg8::EpiWin2, pg8::StaticOrder, true, true>(lds, g, S, E); }
    XBAR();
    {
        const int lane = LANE, gw = GW, ngw = NGW;
        const bf16_t* U = WSP(WS_R2); bf16_t* PL = WSP(WS_R2 + 3 * R2S); float* out = KOUT; const float* cpool = KIN(4);
        for (int t = gw; t < 2048 + 16; t += ngw) {
            if (t < 2048) { const int b = t >> 6, c = (t >> 1) & 31, hs = t & 1; pool_task(U, PL, b * SEQ, SEQ, 64 * c, hs, 0, nullptr, lane); }
            else { const int b = (t - 2048) >> 1, hs = t & 1; pool_task(U, PL, MP + b * SSEQ, SSEQ, 0, hs, 4096, cpool + (size_t)b * 15 * DM, lane); }
        }
        for (int i = blockIdx.x * NTHREADS + TID; i < 40 * 15 * 256; i += gridDim.x * NTHREADS) {
            const int c4 = i & 255, r = (i >> 8) % 15, s = i / (15 * 256);
            const int row = s < 32 ? s * SEQ + SEQ - 15 + r : MP + (s - 32) * SSEQ + SSEQ - 15 + r;
            const u32x2 w = *(const u32x2*)(U + (size_t)row * DM + 4 * c4);
            float* dst = s < 32 ? out + O_POOLP + ((size_t)s * 15 + r) * DM + 4 * c4 : out + O_POOLS + ((size_t)(s - 32) * 15 + r) * DM + 4 * c4;
            *(f32x4*)dst = (f32x4){bflo(w.x), bfhi(w.x), bflo(w.y), bfhi(w.y)};
        }
    }
    small_gemm16<SM_GATE0>(lds, WSP(WS_R1) + (size_t)MP * DINNER, WSP(WS_WPS), DINNER, WSP(WS_R2 + R2S), nullptr);
    { pg8::Gemm g{WSP(WS_R1), WSP(WS_WPS), MP, DM, DINNER}; pg8::StaticOrder S; S.init(MP, DM, gridDim.x, blockIdx.x); pg8::EpiGate<0> E{WSP(WS_R2 + R2S), nullptr};
      pg8::gemm_phase<pg8::EpiGate<0>, pg8::StaticOrder, true, true>(lds, g, S, E); }
    XBAR();
    small_gemm16<SM_GATE1>(lds, WSP(WS_R2 + 3 * R2S) + (size_t)MP * DM, WSP(WS_WCOMB), DM, WSP(WS_R2 + 2 * R2S), WSP(WS_R2 + R2S));
    { pg8::Gemm g{WSP(WS_R2 + 3 * R2S), WSP(WS_WCOMB), MP, DM, DM}; pg8::StaticOrder S; S.init(MP, DM, gridDim.x, blockIdx.x); pg8::EpiGate<1> E{WSP(WS_R2 + 2 * R2S), WSP(WS_R2 + R2S)};
      pg8::gemm_phase<pg8::EpiGate<1>, pg8::StaticOrder, true, true>(lds, g, S, E); }
    XBAR();
    small_gemm16<SM_BF16>(lds, WSP(WS_R2 + 2 * R2S) + (size_t)MP * DM, WSP(WS_WOUT), DM, WSP(WS_R1), nullptr);
    { pg8::Gemm g{WSP(WS_R2 + 2 * R2S), WSP(WS_WOUT), MP, DM, DM}; pg8::StaticOrder S; S.init(MP, DM, gridDim.x, blockIdx.x); pg8::EpiBf16 E{WSP(WS_R1), DM};
      pg8::gemm_phase<pg8::EpiBf16, pg8::StaticOrder, true, true>(lds, g, S, E); }
    XBAR();
    { const int lane = LANE, gw = GW, ngw = NGW; const float* gp = KIN(11); float* out = KOUT; const bf16_t* F = WSP(WS_R1); bf16_t* XB = WSP(WS_XB);
      for (int m = 4 * gw; m < MV; m += 4 * ngw) post_rows2<4, false>(XB + (size_t)m * DM, (float*)(KWS + WS_RN) + m, F + (size_t)m * DM, gp, 1.0f, nullptr, lane); }
    XBAR();
    small_gemm<SM_SWIGLU>(lds, WSP(WS_XB) + (size_t)MP * DM, WSP(WS_WGU2), 2 * DFF, DM, WSP(WS_R2), nullptr, nullptr, nullptr);
    { pg8::Gemm g{WSP(WS_XB), WSP(WS_WGU2), MP, 2 * DFF, DM}; pg8::StaticOrder S; S.init(MP, 2 * DFF, gridDim.x, blockIdx.x); pg8::EpiSwiglu E{WSP(WS_R2), DFF};
      pg8::gemm_phase<pg8::EpiSwiglu, pg8::StaticOrder, true, true>(lds, g, S, E); }
    XBAR();
    small_gemm16<SM_BF16>(lds, WSP(WS_R2) + (size_t)MP * DFF, WSP(WS_WD2), DFF, WSP(WS_R1), nullptr);
    { pg8::Gemm g{WSP(WS_R2), WSP(WS_WD2), MP, DM, DFF, 1}; pg8::StaticOrder S; S.init(MP, DM, gridDim.x, blockIdx.x); pg8::EpiBf16 E{WSP(WS_R1), DM};
      pg8::gemm_phase<pg8::EpiBf16, pg8::StaticOrder, true, true>(lds, g, S, E); }
    XBAR();
    { const int lane = LANE, gw = GW, ngw = NGW; const float* gp = KIN(25); float* out = KOUT; const bf16_t* F = WSP(WS_R1);
      for (int m = 4 * gw; m < MV; m += 4 * ngw) post_rows2<4, true>(WSP(WS_XB) + (size_t)m * DM, (float*)(KWS + WS_RN) + m, F + (size_t)m * DM, gp, 0.5f, out + (size_t)m * DM, lane); }
}

extern "C" void kernel_launch(void* const* d_in, const int* in_sizes, int n_in, void* d_out, int out_size, void* d_ws, size_t ws_size, hipStream_t stream) {
    static int grid = 0;
    if (grid == 0) {
        if (n_in != 29 || ws_size < WS_END) { fprintf(stderr, "kernel_launch: unexpected n_in %d / ws_size %zu (need %zu)\n", n_in, ws_size, (size_t)WS_END); grid = -1; return; }
        int dev = 0, cus = 0, per_cu = 0;
        hipGetDevice(&dev); hipDeviceGetAttribute(&cus, hipDeviceAttributeMultiprocessorCount, dev);
        if (hipFuncSetAttribute((const void*)hybrid_fwd, hipFuncAttributeMaxDynamicSharedMemorySize, LDS_BYTES) != hipSuccess) { fprintf(stderr, "kernel_launch: hipFuncSetAttribute failed\n"); grid = -1; return; }
        if (hipOccupancyMaxActiveBlocksPerMultiprocessor(&per_cu, (const void*)hybrid_fwd, NTHREADS, LDS_BYTES) != hipSuccess || per_cu < 1) { fprintf(stderr, "kernel_launch: occupancy query says %d\n", per_cu); per_cu = 1; }
        (void)hipGetLastError();
        grid = cus * (per_cu > 1 ? 1 : per_cu);
        fprintf(stderr, "kernel_launch: grid %d (cus %d, per_cu %d), ws %zu\n", grid, cus, per_cu, ws_size);
    }
    if (grid < 0) return;
    Params p{};
    for (int i = 0; i < 29; ++i) p.in[i] = (const float*)d_in[i];
    p.out = (float*)d_out; p.ws = (unsigned char*)d_ws;
    void* args[] = {&p};
    hipError_t e = hipLaunchCooperativeKernel((const void*)hybrid_fwd, dim3(grid), dim3(NTHREADS), args, LDS_BYTES, stream);
    if (e != hipSuccess) fprintf(stderr, "kernel_launch: cooperative launch failed: %s (grid %d)\n", hipGetErrorString(e), grid);
}
```

```cpp
#include <hip/hip_runtime.h>
#include <hip/hip_cooperative_groups.h>
#include <cstdio>
#include <cstdint>
namespace cg = cooperative_groups;
namespace pg8 {
#define PG8_LAS __attribute__((address_space(3)))
typedef unsigned short bf16_t;
typedef short bf16x8 __attribute__((ext_vector_type(8)));
typedef float f32x4 __attribute__((ext_vector_type(4)));
typedef unsigned u32x4 __attribute__((ext_vector_type(4)));
constexpr int BM = 256, BK = 64, HALF = 128, HTB = HALF * BK * 2  , STAGE_BYTES = 8 * HTB, NXCD = 8, WGM = 8;

__host__ __device__ __forceinline__ int lds_byte(int r, int c) { const int st = (r >> 4) * 2 + (c >> 5), rr = r & 15, cc = c & 31, ob = rr * 64 + cc * 2; return st * 1024 + (ob ^ (((ob >> 9) & 1) << 5)); }
__host__ __device__ __forceinline__ void stage_rc(int b, int& R, int& C) { const int st = b / 1024, sb = b % 1024, swz = sb ^ (((sb >> 9) & 1) << 5); R = (st >> 1) * 16 + swz / 64; C = (st & 1) * 32 + (swz % 64) / 2; }
__host__ __device__ __forceinline__ int perm32(int rho) { const int n = rho >> 4, i = rho & 15; return 8 * (i >> 2) + 4 * n + (i & 3); }

struct Unit { int pm, pn; };
struct Gemm { const bf16_t* A; const bf16_t* Bt; int M, N, K; int ablk; };

struct StaticOrder {
    int nM, nN, nwg, G, c;
    __host__ __device__ void init(int M, int N, int G_, int c_) { nM = M / BM; nN = N / BM; nwg = nM * nN; G = G_; c = c_; }
    __host__ __device__ bool next(int i, Unit& u) const {
        const long L = (long)i * G + c; if (L >= nwg) return false;
        int wgid = (int)L; { const int q = nwg / NXCD, r = nwg % NXCD, xcd = wgid % NXCD, off = wgid / NXCD; wgid = (xcd < r ? xcd * (q + 1) : r * (q + 1) + (xcd - r) * q) + off; }
        const int nig = WGM * nN, gid = wgid / nig, fm = gid * WGM, gsz = (nM - fm) < WGM ? (nM - fm) : WGM;
        u.pm = fm + ((wgid % nig) % gsz); u.pn = (wgid % nig) / gsz; return true;
    }
    __device__ __forceinline__ void a_ready(const Unit&) const {}
    __device__ __forceinline__ void done(const Unit&) const {}
};

typedef __bf16 bf16x2_t __attribute__((ext_vector_type(2)));
typedef float f32x2 __attribute__((ext_vector_type(2)));
__device__ __forceinline__ unsigned pk2(float lo, float hi) { f32x2 v = {lo, hi}; bf16x2_t r = __builtin_convertvector(v, bf16x2_t); return __builtin_bit_cast(unsigned, r); }
__device__ __forceinline__ float bflo(unsigned u) { return __uint_as_float(u << 16); }
__device__ __forceinline__ float bfhi(unsigned u) { return __uint_as_float(u & 0xffff0000u); }
__device__ __forceinline__ float fast_sigmoid(float x) { return __builtin_amdgcn_rcpf(1.0f + __builtin_amdgcn_exp2f(-1.44269504089f * x)); }
__device__ __forceinline__ float fast_silu(float x) { return x * fast_sigmoid(x); }
__device__ __forceinline__ f32x4 sigmoid4(f32x4 x) {
    const f32x4 t = x * (-1.44269504089f); f32x4 ex;
    ex[0] = __builtin_amdgcn_exp2f(t[0]); ex[1] = __builtin_amdgcn_exp2f(t[1]); ex[2] = __builtin_amdgcn_exp2f(t[2]); ex[3] = __builtin_amdgcn_exp2f(t[3]);
    const f32x4 d = ex + 1.0f; f32x4 r;
    r[0] = __builtin_amdgcn_rcpf(d[0]); r[1] = __builtin_amdgcn_rcpf(d[1]); r[2] = __builtin_amdgcn_rcpf(d[2]); r[3] = __builtin_amdgcn_rcpf(d[3]);
    return r;
}
__device__ __forceinline__ f32x4 silu4(f32x4 x) {
    const f32x4 t = x * (-1.44269504089f); f32x4 ex;
    ex[0] = __builtin_amdgcn_exp2f(t[0]); ex[1] = __builtin_amdgcn_exp2f(t[1]); ex[2] = __builtin_amdgcn_exp2f(t[2]); ex[3] = __builtin_amdgcn_exp2f(t[3]);
    const f32x4 d = ex + 1.0f; f32x4 r;
    r[0] = __builtin_amdgcn_rcpf(d[0]); r[1] = __builtin_amdgcn_rcpf(d[1]); r[2] = __builtin_amdgcn_rcpf(d[2]); r[3] = __builtin_amdgcn_rcpf(d[3]);
    return x * r;
}

struct EpiBf16 {
    static constexpr bool PERM = true, AFTER_DRAIN = false;
    bf16_t* O; int ldc;
    __device__ __forceinline__ void operator()(const f32x4 (&acc)[2][2][4][2], const Unit& u, int wr, int wc, int fr, int fq) const {
        const int row0 = u.pm * BM + wr * 64 + fr; const int col0 = u.pn * BM + wc * 32 + 8 * fq;
#pragma unroll
        for (int ai = 0; ai < 2; ++ai)
#pragma unroll
            for (int m = 0; m < 4; ++m) { bf16_t* rowp = O + (size_t)(row0 + ai * HALF + m * 16) * ldc + col0;
#pragma unroll
                for (int bj = 0; bj < 2; ++bj) { const f32x4 v0 = acc[ai][bj][m][0], v1 = acc[ai][bj][m][1];
                    u32x4 w; w.x = pk2(v0[0], v0[1]); w.y = pk2(v0[2], v0[3]); w.z = pk2(v1[0], v1[1]); w.w = pk2(v1[2], v1[3]);
                    *(u32x4*)(rowp + bj * HALF) = w; } }
    }
};
struct EpiSwiglu {
    static constexpr bool PERM = false, AFTER_DRAIN = false;
    bf16_t* H; int ldh;
    __device__ __forceinline__ void operator()(const f32x4 (&acc)[2][2][4][2], const Unit& u, int wr, int wc, int fr, int fq) const {
        const int row0 = u.pm * BM + wr * 64 + fr; const int hcol = u.pn * 128 + wc * 32 + 8 * fq;
#pragma unroll
        for (int ai = 0; ai < 2; ++ai)
#pragma unroll
            for (int m = 0; m < 4; ++m) {
                bf16_t* rowp = H + (((size_t)u.pm * (ldh >> 6) + (hcol >> 6)) * BM + (wr * 64 + fr + ai * HALF + m * 16)) * 64 + (hcol & 63);
                const f32x4 g0 = acc[ai][0][m][0], u0 = acc[ai][0][m][1], g1 = acc[ai][1][m][0], u1 = acc[ai][1][m][1];
                const f32x4 h0 = silu4(g0) * u0, h1 = silu4(g1) * u1;
                u32x4 w; w.x = pk2(h0[0], h0[1]); w.y = pk2(h0[2], h0[3]); w.z = pk2(h1[0], h1[1]); w.w = pk2(h1[2], h1[3]);
                *(u32x4*)rowp = w; }
    }
};
struct EpiWin1 {
    static constexpr bool PERM = true, AFTER_DRAIN = false;
    bf16_t* Z; bf16_t* XBC; float* DT; const float* dt_bias;
    __device__ __forceinline__ void operator()(const f32x4 (&acc)[2][2][4][2], const Unit& u, int wr, int wc, int fr, int fq) const {
        const int row0 = u.pm * BM + wr * 64 + fr;
        if (u.pn < 24) {
            bf16_t* base; int ldc, colt;
            if (u.pn < 8) { base = Z; ldc = 2048; colt = u.pn * BM; } else { base = XBC; ldc = 4096; colt = (u.pn - 8) * BM; }
            const int col0 = colt + wc * 32 + 8 * fq;
#pragma unroll
            for (int ai = 0; ai < 2; ++ai)
#pragma unroll
                for (int m = 0; m < 4; ++m) { bf16_t* rowp = base + (size_t)(row0 + ai * HALF + m * 16) * ldc + col0;
#pragma unroll
                    for (int bj = 0; bj < 2; ++bj) { const f32x4 v0 = acc[ai][bj][m][0], v1 = acc[ai][bj][m][1];
                        u32x4 w; w.x = pk2(v0[0], v0[1]); w.y = pk2(v0[2], v0[3]); w.z = pk2(v1[0], v1[1]); w.w = pk2(v1[2], v1[3]);
                        *(u32x4*)(rowp + bj * HALF) = w; } }
        } else if (wc == 0) {
            const int col0 = 8 * fq;
            const f32x4 b0 = *(const f32x4*)(dt_bias + col0), b1 = *(const f32x4*)(dt_bias + col0 + 4);
#pragma unroll
            for (int ai = 0; ai < 2; ++ai)
#pragma unroll
                for (int m = 0; m < 4; ++m) { float* rowp = DT + (size_t)(row0 + ai * HALF + m * 16) * 32 + col0;
                    f32x4 v0 = acc[ai][0][m][0] + b0, v1 = acc[ai][0][m][1] + b1;
#pragma unroll
                    for (int j = 0; j < 4; ++j) { v0[j] = fmaxf(v0[j], 0.f) + log1pf(expf(-fabsf(v0[j]))); v1[j] = fmaxf(v1[j], 0.f) + log1pf(expf(-fabsf(v1[j]))); }
                    *(f32x4*)rowp = v0; *(f32x4*)(rowp + 4) = v1; }
        }
    }
};
struct EpiWin2 {
    static constexpr bool PERM = true, AFTER_DRAIN = false;
    bf16_t* U; size_t stride;
    __device__ __forceinline__ void operator()(const f32x4 (&acc)[2][2][4][2], const Unit& u, int wr, int wc, int fr, int fq) const {
        const int row0 = u.pm * BM + wr * 64 + fr; const int t = u.pn >> 2; const bool sg = t != 0;
        bf16_t* base = U + (size_t)t * stride; const int col0 = (u.pn & 3) * BM + wc * 32 + 8 * fq;
#pragma unroll
        for (int ai = 0; ai < 2; ++ai)
#pragma unroll
            for (int m = 0; m < 4; ++m) { bf16_t* rowp = base + (size_t)(row0 + ai * HALF + m * 16) * 1024 + col0;
#pragma unroll
                for (int bj = 0; bj < 2; ++bj) { f32x4 v0 = acc[ai][bj][m][0], v1 = acc[ai][bj][m][1];
                    if (sg) { v0 = sigmoid4(v0); v1 = sigmoid4(v1); }
                    u32x4 w; w.x = pk2(v0[0], v0[1]); w.y = pk2(v0[2], v0[3]); w.z = pk2(v1[0], v1[1]); w.w = pk2(v1[2], v1[3]);
                    *(u32x4*)(rowp + bj * HALF) = w; } }
    }
};
template <int MODE> struct EpiGate {
    static constexpr bool PERM = true, AFTER_DRAIN = false;
    bf16_t* G; const bf16_t* T;
    __device__ __forceinline__ void operator()(const f32x4 (&acc)[2][2][4][2], const Unit& u, int wr, int wc, int fr, int fq) const {
        const int row0 = u.pm * BM + wr * 64 + fr; const int col0 = u.pn * BM + wc * 32 + 8 * fq;
#pragma unroll
        for (int ai = 0; ai < 2; ++ai)
#pragma unroll
            for (int m = 0; m < 4; ++m) { const size_t off = (size_t)(row0 + ai * HALF + m * 16) * 1024 + col0;
#pragma unroll
                for (int bj = 0; bj < 2; ++bj) { const f32x4 v0 = acc[ai][bj][m][0], v1 = acc[ai][bj][m][1];
                    const u32x4 g = *(const u32x4*)(G + off + bj * HALF);
                    float r[8] = {bflo(g.x) * v0[0], bfhi(g.x) * v0[1], bflo(g.y) * v0[2], bfhi(g.y) * v0[3], bflo(g.z) * v1[0], bfhi(g.z) * v1[1], bflo(g.w) * v1[2], bfhi(g.w) * v1[3]};
                    if (MODE == 1) { const u32x4 t = *(const u32x4*)(T + off + bj * HALF);
                        r[0] += bflo(t.x); r[1] += bfhi(t.x); r[2] += bflo(t.y); r[3] += bfhi(t.y); r[4] += bflo(t.z); r[5] += bfhi(t.z); r[6] += bflo(t.w); r[7] += bfhi(t.w); }
                    u32x4 w; w.x = pk2(r[0], r[1]); w.y = pk2(r[2], r[3]); w.z = pk2(r[4], r[5]); w.w = pk2(r[6], r[7]);
                    *(u32x4*)(G + off + bj * HALF) = w; } }
    }
};

template <class Epi, class Sched, bool ALIGN_EPI = false, bool SP2 = false>
__device__ __forceinline__ void gemm_phase(PG8_LAS unsigned char* lds, const Gemm g, const Sched& S, const Epi& E) {
    int tid_ = threadIdx.x; asm volatile("" : "+v"(tid_));
    const int tid = tid_, wid = __builtin_amdgcn_readfirstlane(tid >> 6), lane = tid & 63, wr = wid >> 2, wc = wid & 3, fr = lane & 15, fq = lane >> 4;
    const int K = g.K, nt = K / BK;
    unsigned voffA[2], voffB[2];
#pragma unroll
    for (int i = 0; i < 2; ++i) { int R, C; stage_rc(tid * 16 + i * 8192, R, C); const int Rb = Epi::PERM ? ((R & ~31) + perm32(R & 31)) : R;
        voffA[i] = g.ablk ? (unsigned)(R * BK + C) * 2u : (unsigned)(R * K + C) * 2u; voffB[i] = (unsigned)(Rb * K + C) * 2u; }
    const size_t kstep = (size_t)(BK * 2);
    const size_t hstep = (size_t)HALF * K * 2;
    const size_t tstep = 2 * hstep;
    const size_t kstepA = g.ablk ? (size_t)(BM * BK * 2) : kstep, hstepA = g.ablk ? (size_t)(HALF * BK * 2) : hstep, tstepA = g.ablk ? (size_t)(K / BK) * (BM * BK * 2) : tstep;
    const unsigned ldsw = (unsigned)wid * 1024u;
    const int aoff = lds_byte(wr * 64 + fr, fq * 8), boff = lds_byte(wc * 32 + fr, fq * 8);
#define PG8_SA(b, h) (((b) * 2 + (h)) * HTB)
#define PG8_SB(b, h) ((4 + (b) * 2 + (h)) * HTB)
#define PG8_STAGE(bufoff, gbase, voff) do { _Pragma("unroll") for (int _i = 0; _i < 2; ++_i) \
        __builtin_amdgcn_global_load_lds((const unsigned*)((const char*)(gbase) + (voff)[_i]), (PG8_LAS unsigned*)(lds + (bufoff) + ldsw + _i * 8192), 16, 0, 0); } while (0)
#define PG8_LDA(dst, b, h) do { _Pragma("unroll") for (int m = 0; m < 4; ++m) _Pragma("unroll") for (int k = 0; k < 2; ++k) dst[m][k] = *(const PG8_LAS bf16x8*)(lds + PG8_SA(b, h) + aoff + m * 2048 + k * 1024); } while (0)
#define PG8_LDB(dst, b, h) do { _Pragma("unroll") for (int n = 0; n < 2; ++n) _Pragma("unroll") for (int k = 0; k < 2; ++k) dst[n][k] = *(const PG8_LAS bf16x8*)(lds + PG8_SB(b, h) + boff + n * 2048 + k * 1024); } while (0)
#define PG8_MMA(ai, bj, At, Bt) do { __builtin_amdgcn_s_setprio(1); _Pragma("unroll") for (int m = 0; m < 4; ++m) _Pragma("unroll") for (int n = 0; n < 2; ++n) _Pragma("unroll") for (int k = 0; k < 2; ++k) \
        acc[ai][bj][m][n] = __builtin_amdgcn_mfma_f32_16x16x32_bf16(Bt[n][k], At[m][k], acc[ai][bj][m][n], 0, 0, 0); __builtin_amdgcn_s_setprio(0); } while (0)
#define PG8_WAIT_V(n) asm volatile("s_waitcnt vmcnt(" #n ")" ::: "memory")
#define PG8_WAIT_L(n) asm volatile("s_waitcnt lgkmcnt(" #n ")" ::: "memory")
#define PG8_BAR __builtin_amdgcn_s_barrier()
#define PG8_SCHED __builtin_amdgcn_sched_barrier(0)
    Unit cur, nxt; int ui = 0;
    if (!S.next(0, cur)) return;
    f32x4 acc[2][2][4][2];
#pragma unroll
    for (int a = 0; a < 2; ++a)
#pragma unroll
        for (int b = 0; b < 2; ++b)
#pragma unroll
            for (int m = 0; m < 4; ++m)
#pragma unroll
                for (int n = 0; n < 2; ++n) acc[a][b][m][n] = (f32x4){0.f, 0.f, 0.f, 0.f};
    bf16x8 At[4][2], B0[2][2], B1[2][2];
    const char* cA = (const char*)g.A + (size_t)cur.pm * tstepA; const char* cB = (const char*)g.Bt + (size_t)cur.pn * tstep;
    S.a_ready(cur);
    if constexpr (SP2) {
        PG8_STAGE(PG8_SB(0, 0), cB, voffB); PG8_STAGE(PG8_SB(0, 1), cB + hstep, voffB); PG8_STAGE(PG8_SA(0, 0), cA, voffA); PG8_STAGE(PG8_SA(0, 1), cA + hstepA, voffA);
        if (wr == 1) PG8_BAR;
        PG8_WAIT_V(2); PG8_BAR;
        PG8_STAGE(PG8_SB(1, 0), cB + kstep, voffB); PG8_STAGE(PG8_SA(1, 0), cA + kstepA, voffA); PG8_STAGE(PG8_SB(1, 1), cB + hstep + kstep, voffB);
        PG8_WAIT_V(6); PG8_BAR;
    } else {
        PG8_STAGE(PG8_SB(0, 0), cB, voffB); PG8_STAGE(PG8_SA(0, 0), cA, voffA); PG8_STAGE(PG8_SB(0, 1), cB + hstep, voffB); PG8_STAGE(PG8_SA(0, 1), cA + hstepA, voffA);
        if (wr == 1) PG8_BAR;
        PG8_WAIT_V(4); PG8_BAR;
        PG8_STAGE(PG8_SB(1, 0), cB + kstep, voffB); PG8_STAGE(PG8_SA(1, 0), cA + kstepA, voffA); PG8_STAGE(PG8_SB(1, 1), cB + hstep + kstep, voffB);
        PG8_WAIT_V(6); PG8_BAR;
    }
    for (;;) {
        const bool has_next = S.next(ui + 1, nxt);
        const char* nA = has_next ? (const char*)g.A + (size_t)nxt.pm * tstepA : cA; const char* nB = has_next ? (const char*)g.Bt + (size_t)nxt.pn * tstep : cB;
        for (int t = 0; t < nt; t += 2) {
            const bool last = (t == nt - 2);
            const char* a1 = cA + (size_t)(t + 1) * kstepA;
            const char* a2 = last ? nA : cA + (size_t)(t + 2) * kstepA; const char* b2 = last ? nB : cB + (size_t)(t + 2) * kstep;
            const char* a3 = a2 + kstepA; const char* b3 = b2 + kstep;
            if (last && has_next) S.a_ready(nxt);
            if constexpr (SP2) {
            PG8_LDB(B0, 0, 0); PG8_LDB(B1, 0, 1); PG8_SCHED; PG8_LDA(At, 0, 0); PG8_STAGE(PG8_SA(1, 1), a1 + hstepA, voffA);
            PG8_WAIT_V(8); PG8_WAIT_L(0); PG8_BAR; PG8_MMA(0, 0, At, B0); PG8_MMA(0, 1, At, B1); PG8_BAR; PG8_SCHED;
            PG8_LDA(At, 0, 1); PG8_STAGE(PG8_SB(0, 0), b2, voffB); PG8_STAGE(PG8_SB(0, 1), b2 + hstep, voffB); PG8_STAGE(PG8_SA(0, 0), a2, voffA);
            PG8_WAIT_V(8); PG8_WAIT_L(0); PG8_BAR; PG8_MMA(1, 0, At, B0); PG8_MMA(1, 1, At, B1); PG8_BAR; PG8_SCHED;
            PG8_LDB(B0, 1, 0); PG8_LDB(B1, 1, 1); PG8_SCHED; PG8_LDA(At, 1, 0); PG8_STAGE(PG8_SA(0, 1), a2 + hstepA, voffA);
            PG8_WAIT_V(8); PG8_WAIT_L(0); PG8_BAR; PG8_MMA(0, 0, At, B0); PG8_MMA(0, 1, At, B1); PG8_BAR; PG8_SCHED;
            PG8_LDA(At, 1, 1); PG8_STAGE(PG8_SB(1, 0), b3, voffB); PG8_STAGE(PG8_SB(1, 1), b3 + hstep, voffB); PG8_STAGE(PG8_SA(1, 0), a3, voffA);
            PG8_WAIT_V(8); PG8_WAIT_L(0); PG8_BAR; PG8_MMA(1, 0, At, B0); PG8_MMA(1, 1, At, B1); PG8_BAR; PG8_SCHED;
            } else {
            PG8_LDB(B0, 0, 0); PG8_SCHED; PG8_LDA(At, 0, 0); PG8_STAGE(PG8_SA(1, 1), a1 + hstepA, voffA);
            PG8_WAIT_L(8); PG8_BAR; PG8_WAIT_L(0); PG8_MMA(0, 0, At, B0); PG8_BAR; PG8_SCHED;
            PG8_LDB(B1, 0, 1); PG8_STAGE(PG8_SB(0, 0), b2, voffB);
            PG8_BAR; PG8_WAIT_L(0); PG8_MMA(0, 1, At, B1); PG8_BAR;
            PG8_LDA(At, 0, 1); PG8_STAGE(PG8_SA(0, 0), a2, voffA);
            PG8_BAR; PG8_WAIT_L(0); PG8_MMA(1, 0, At, B0); PG8_BAR; PG8_SCHED;
            PG8_STAGE(PG8_SB(0, 1), b2 + hstep, voffB);
            PG8_WAIT_V(6); PG8_BAR; PG8_MMA(1, 1, At, B1); PG8_BAR;
            PG8_LDB(B0, 1, 0); PG8_SCHED; PG8_LDA(At, 1, 0); PG8_STAGE(PG8_SA(0, 1), a2 + hstepA, voffA);
            PG8_WAIT_L(8); PG8_BAR; PG8_WAIT_L(0); PG8_MMA(0, 0, At, B0); PG8_BAR; PG8_SCHED;
            PG8_LDB(B1, 1, 1); PG8_STAGE(PG8_SB(1, 0), b3, voffB);
            PG8_BAR; PG8_WAIT_L(0); PG8_MMA(0, 1, At, B1); PG8_BAR;
            PG8_LDA(At, 1, 1); PG8_STAGE(PG8_SA(1, 0), a3, voffA);
            PG8_BAR; PG8_WAIT_L(0); PG8_MMA(1, 0, At, B0); PG8_BAR; PG8_SCHED;
            PG8_STAGE(PG8_SB(1, 1), b3 + hstep, voffB);
            PG8_WAIT_V(6); PG8_BAR; PG8_MMA(1, 1, At, B1); PG8_BAR;
            }
        }
        if constexpr (ALIGN_EPI) { if (wr == 0) PG8_BAR; }
        if constexpr (!Epi::AFTER_DRAIN) { E(acc, cur, wr, wc, fr, fq); S.done(cur); }
        if (!has_next) break;
#pragma unroll
        for (int a = 0; a < 2; ++a)
#pragma unroll
            for (int b = 0; b < 2; ++b)
#pragma unroll
                for (int m = 0; m < 4; ++m)
#pragma unroll
                    for (int n = 0; n < 2; ++n) acc[a][b][m][n] = (f32x4){0.f, 0.f, 0.f, 0.f};
        cur = nxt; cA = nA; cB = nB; ++ui;
        if constexpr (ALIGN_EPI) { if (wr == 1) PG8_BAR; }
    }
    PG8_WAIT_V(0);
    if constexpr (!ALIGN_EPI) { if (wr == 0) PG8_BAR; }
    PG8_BAR;
    if constexpr (Epi::AFTER_DRAIN) { E.fused(acc, cur, wr, wc, fr, fq, lds, wid, lane); S.done(cur); }
#undef PG8_SA
#undef PG8_SB
#undef PG8_STAGE
#undef PG8_LDA
#undef PG8_LDB
#undef PG8_MMA
#undef PG8_WAIT_V
#undef PG8_WAIT_L
#undef PG8_BAR
#undef PG8_SCHED
}
}

#define LAS __attribute__((address_space(3)))
typedef unsigned short bf16_t;
typedef short bf16x8 __attribute__((ext_vector_type(8)));
typedef float f32x4 __attribute__((ext_vector_type(4)));
typedef float f32x16 __attribute__((ext_vector_type(16)));
typedef unsigned u32x4 __attribute__((ext_vector_type(4)));
typedef unsigned u32x2 __attribute__((ext_vector_type(2)));
using pg8::pk2; using pg8::bflo; using pg8::bfhi; using pg8::fast_sigmoid; using pg8::fast_silu; using pg8::silu4;

constexpr int DM = 1024, SEQ = 2048, NB = 32, DFF = 2816, DINNER = 2048, CONVD = 4096;
constexpr int SB = 8, SSEQ = 16;
constexpr int MP = NB * SEQ;
constexpr int MS = SB * SSEQ;
constexpr int MV = MP + MS;
constexpr int MT = MP + 256;
constexpr int NWIN1 = 6400, NWIN = 9472;
constexpr float EPS = 1e-6f;
constexpr int NTHREADS = 512, NWAVES = 8;
constexpr int LDS_BYTES = 147456;

constexpr size_t O_YP = 0, O_YS = 67108864, O_CONVP = 67239936, O_SSMP = 67633152, O_POOLP = 76021760, O_CONVS = 76513280, O_SSMS = 76611584, O_POOLS = 78708736;

constexpr size_t MiB = 1u << 20;
constexpr size_t WS_WGU1 = 1 * MiB;
constexpr size_t WS_WD1 = WS_WGU1 + (size_t)5632 * 1024 * 2;
constexpr size_t WS_WIN = WS_WD1 + (size_t)1024 * 2816 * 2;
constexpr size_t WS_WPS = WS_WIN + (size_t)NWIN * 1024 * 2;
constexpr size_t WS_WCOMB = WS_WPS + (size_t)1024 * 2048 * 2;
constexpr size_t WS_WOUT = WS_WCOMB + (size_t)1024 * 1024 * 2;
constexpr size_t WS_WGU2 = WS_WOUT + (size_t)1024 * 1024 * 2;
constexpr size_t WS_WD2 = WS_WGU2 + (size_t)5632 * 1024 * 2;
constexpr size_t WS_WEND = WS_WD2 + (size_t)1024 * 2816 * 2;
static_assert(WS_WEND <= 61 * MiB, "weights");
constexpr size_t WS_DT = 61 * MiB;
constexpr size_t WS_RN = 69 * MiB + 512 * 1024;
constexpr size_t WS_XB = 70 * MiB;
constexpr size_t WS_R1 = 199 * MiB;
constexpr size_t WS_R2 = 456 * MiB;
constexpr size_t WS_END = WS_R2 + (size_t)MT * 4096 * 2;
static_assert(WS_DT + (size_t)MT * 32 * 4 <= WS_RN && WS_RN + (size_t)MT * 4 <= WS_XB && WS_XB + (size_t)MT * 1024 * 2 <= WS_R1 && WS_R1 + (size_t)MT * 2048 * 2 <= WS_R2 && WS_END <= 1024 * MiB, "ws map");

__device__ __forceinline__ float wave_sum(float v) {
#pragma unroll
    for (int o = 1; o < 64; o <<= 1) v += __shfl_xor(v, o);
    return v;
}

template <int MODE>
__device__ __forceinline__ void wt_item(const float* W0, const float* W1, int N, int K, const float* kscale, bf16_t* WT, int nblk, LAS float* scr, int item, int lane) {
    const int kb = item / nblk, nb = item % nblk, k0 = 64 * kb, n0 = 32 * nb;
    const int np = n0 + (lane & 31);
    const float* src = W0; int col = np;
    if (MODE == 1) { const int pn = np >> 8, c = np & 255, bj = c >> 7, wc = (c >> 5) & 3, n = (c >> 4) & 1, fq = (c >> 2) & 3, i = c & 3;
        col = 128 * pn + 32 * wc + 8 * fq + 4 * bj + i; src = n ? W1 : W0; }
    if (MODE == 2) { col = np < 6176 ? np : (np < 6400 ? -1 : np - 224); }
    {
        const int n4 = 4 * (lane & 7), npq = n0 + n4;
        const float* srcq = W0; int colq = npq;
        if (MODE == 1) { const int pn = npq >> 8, c = npq & 255, bj = c >> 7, wc = (c >> 5) & 3, n = (c >> 4) & 1, fq = (c >> 2) & 3;
            colq = 128 * pn + 32 * wc + 8 * fq + 4 * bj; srcq = n ? W1 : W0; }
        if (MODE == 2) { colq = npq < 6176 ? npq : (npq < 6400 ? -1 : npq - 224); }
#pragma unroll
        for (int i = 0; i < 8; ++i) { const int kk = 8 * i + (lane >> 3);
            f32x4 v = {0.f, 0.f, 0.f, 0.f};
            if (colq >= 0) { v = *(const f32x4*)(srcq + (size_t)(k0 + kk) * N + colq); if (kscale) v = v * kscale[k0 + kk]; }
            LAS float* d = scr + kk * 33 + n4; d[0] = v[0]; d[1] = v[1]; d[2] = v[2]; d[3] = v[3]; }
    }
    asm volatile("s_waitcnt lgkmcnt(0)" ::: "memory");
    const int c = lane & 7;
#pragma unroll
    for (int j = 0; j < 4; ++j) { const int n = (lane >> 3) + 8 * j; const LAS float* s = scr + (8 * c) * 33 + n;
        u32x4 o; o.x = pk2(s[0 * 33], s[1 * 33]); o.y = pk2(s[2 * 33], s[3 * 33]); o.z = pk2(s[4 * 33], s[5 * 33]); o.w = pk2(s[6 * 33], s[7 * 33]);
        *(u32x4*)(WT + (size_t)(n0 + n) * K + k0 + 8 * c) = o; }
    asm volatile("s_waitcnt lgkmcnt(0)" ::: "memory");
}

__device__ __forceinline__ void wcomb_task(const float* mix, const float* scale, const float* wpp, bf16_t* WC, int task, int lane) {
    const int nb = task & 15, klb = (task >> 4) & 31, g = task >> 9;
    const int n = nb * 64 + lane, kl0 = klb * 8;
    float acc[8];
#pragma unroll
    for (int i = 0; i < 8; ++i) acc[i] = 0.f;
    const float* mrow = mix + ((size_t)g * 256 + kl0) * 256;
    for (int j = 0; j < 256; j += 4) {
        const f32x4 sc4 = *(const f32x4*)(scale + 256 * g + j);
        float w[4];
#pragma unroll
        for (int e = 0; e < 4; ++e) w[e] = sc4[e] * wpp[(size_t)(256 * g + j + e) * 1024 + n];
#pragma unroll
        for (int i = 0; i < 8; ++i) { const f32x4 m4 = *(const f32x4*)(mrow + i * 256 + j);
            acc[i] += (m4[0] * w[0] + m4[1] * w[1]) + (m4[2] * w[2] + m4[3] * w[3]); }
    }
    u32x4 o; o.x = pk2(acc[0], acc[1]); o.y = pk2(acc[2], acc[3]); o.z = pk2(acc[4], acc[5]); o.w = pk2(acc[6], acc[7]);
    *(u32x4*)(WC + (size_t)n * 1024 + 256 * g + kl0) = o;
}

__device__ __forceinline__ void norm_row_to_bf16(const float* xrow, bf16_t* orow, int lane) {
    const f32x4* xr = (const f32x4*)xrow + lane;
    f32x4 v[4]; float s = 0.f;
#pragma unroll
    for (int j = 0; j < 4; ++j) { v[j] = xr[64 * j]; s += (v[j].x * v[j].x + v[j].y * v[j].y) + (v[j].z * v[j].z + v[j].w * v[j].w); }
    const float rstd = rsqrtf(wave_sum(s) * (1.f / DM) + EPS);
    u32x2* o8 = (u32x2*)orow + lane;
#pragma unroll
    for (int j = 0; j < 4; ++j) { u32x2 w; w.x = pk2(v[j].x * rstd, v[j].y * rstd); w.y = pk2(v[j].z * rstd, v[j].w * rstd); o8[64 * j] = w; }
}

__device__ __forceinline__ void post_row(const float* xin, const bf16_t* frow, const float* gpost, float c, float* xout, bf16_t* xb, int lane) {
    const f32x4* xr = (const f32x4*)xin + lane; const u32x2* fr = (const u32x2*)frow + lane; const f32x4* gr = (const f32x4*)gpost + lane;
    f32x4 f[4]; float s = 0.f;
#pragma unroll
    for (int j = 0; j < 4; ++j) { const u32x2 w = fr[64 * j]; f[j] = (f32x4){bflo(w.x), bfhi(w.x), bflo(w.y), bfhi(w.y)}; s += (f[j].x * f[j].x + f[j].y * f[j].y) + (f[j].z * f[j].z + f[j].w * f[j].w); }
    const float rf = c * rsqrtf(wave_sum(s) * (1.f / DM) + EPS);
    f32x4 v[4]; float s2 = 0.f;
#pragma unroll
    for (int j = 0; j < 4; ++j) { v[j] = xr[64 * j] + f[j] * rf * gr[64 * j]; s2 += (v[j].x * v[j].x + v[j].y * v[j].y) + (v[j].z * v[j].z + v[j].w * v[j].w); }
    f32x4* xo = (f32x4*)xout + lane;
#pragma unroll
    for (int j = 0; j < 4; ++j) xo[64 * j] = v[j];
    if (xb) {
        const float rstd = rsqrtf(wave_sum(s2) * (1.f / DM) + EPS);
        u32x2* o8 = (u32x2*)xb + lane;
#pragma unroll
        for (int j = 0; j < 4; ++j) { u32x2 w; w.x = pk2(v[j].x * rstd, v[j].y * rstd); w.y = pk2(v[j].z * rstd, v[j].w * rstd); o8[64 * j] = w; }
    }
}


template <int R>
__device__ __forceinline__ void post_rows(const float* xin, const bf16_t* frow, const float* gpost, float c, float* xout, bf16_t* xb, int lane) {
    f32x4 f[R][4], v[R][4]; float s[R];
#pragma unroll
    for (int r = 0; r < R; ++r) { const u32x2* fr = (const u32x2*)(frow + (size_t)r * DM) + lane; const f32x4* xr = (const f32x4*)(xin + (size_t)r * DM) + lane;
#pragma unroll
        for (int j = 0; j < 4; ++j) { const u32x2 w = fr[64 * j]; f[r][j] = (f32x4){bflo(w.x), bfhi(w.x), bflo(w.y), bfhi(w.y)}; v[r][j] = xr[64 * j]; } }
    f32x4 g[4];
#pragma unroll
    for (int j = 0; j < 4; ++j) g[j] = ((const f32x4*)gpost + lane)[64 * j];
#pragma unroll
    for (int r = 0; r < R; ++r) { s[r] = 0.f;
#pragma unroll
        for (int j = 0; j < 4; ++j) s[r] += (f[r][j].x * f[r][j].x + f[r][j].y * f[r][j].y) + (f[r][j].z * f[r][j].z + f[r][j].w * f[r][j].w); }
#pragma unroll
    for (int o = 1; o < 64; o <<= 1) {
#pragma unroll
        for (int r = 0; r < R; ++r) s[r] += __shfl_xor(s[r], o); }
    float s2[R];
#pragma unroll
    for (int r = 0; r < R; ++r) { const float rf = c * rsqrtf(s[r] * (1.f / DM) + EPS); s2[r] = 0.f; f32x4* xo = (f32x4*)(xout + (size_t)r * DM) + lane;
#pragma unroll
        for (int j = 0; j < 4; ++j) { v[r][j] = v[r][j] + f[r][j] * rf * g[j]; s2[r] += (v[r][j].x * v[r][j].x + v[r][j].y * v[r][j].y) + (v[r][j].z * v[r][j].z + v[r][j].w * v[r][j].w); xo[64 * j] = v[r][j]; } }
    if (xb) {
#pragma unroll
        for (int o = 1; o < 64; o <<= 1) {
#pragma unroll
            for (int r = 0; r < R; ++r) s2[r] += __shfl_xor(s2[r], o); }
#pragma unroll
        for (int r = 0; r < R; ++r) { const float rstd = rsqrtf(s2[r] * (1.f / DM) + EPS); u32x2* o8 = (u32x2*)(xb + (size_t)r * DM) + lane;
#pragma unroll
            for (int j = 0; j < 4; ++j) { u32x2 w; w.x = pk2(v[r][j].x * rstd, v[r][j].y * rstd); w.y = pk2(v[r][j].z * rstd, v[r][j].w * rstd); o8[64 * j] = w; } }
    }
}
template <int R>
__device__ __forceinline__ void norm_rows_to_bf16(const float* xrow, bf16_t* orow, float* rn, int lane) {
    f32x4 v[R][4]; float s[R];
#pragma unroll
    for (int r = 0; r < R; ++r) { const f32x4* xr = (const f32x4*)(xrow + (size_t)r * DM) + lane; s[r] = 0.f;
#pragma unroll
        for (int j = 0; j < 4; ++j) v[r][j] = xr[64 * j]; }
#pragma unroll
    for (int r = 0; r < R; ++r)
#pragma unroll
        for (int j = 0; j < 4; ++j) s[r] += (v[r][j].x * v[r][j].x + v[r][j].y * v[r][j].y) + (v[r][j].z * v[r][j].z + v[r][j].w * v[r][j].w);
#pragma unroll
    for (int o = 1; o < 64; o <<= 1) {
#pragma unroll
        for (int r = 0; r < R; ++r) s[r] += __shfl_xor(s[r], o); }
#pragma unroll
    for (int r = 0; r < R; ++r) { const float ms = s[r] * (1.f / DM) + EPS; const float rstd = rsqrtf(ms); u32x2* o8 = (u32x2*)(orow + (size_t)r * DM) + lane; if (lane == 0) rn[r] = ms * rstd;
#pragma unroll
        for (int j = 0; j < 4; ++j) { u32x2 w; w.x = pk2(v[r][j].x * rstd, v[r][j].y * rstd); w.y = pk2(v[r][j].z * rstd, v[r][j].w * rstd); o8[64 * j] = w; } }
}


template <int R, bool FINAL>
__device__ __forceinline__ void post_rows2(bf16_t* xb, float* rn, const bf16_t* frow, const float* gpost, float c, float* yout, int lane) {
    f32x4 f[R][4], v[R][4]; float s[R], rnv[R];
#pragma unroll
    for (int r = 0; r < R; ++r) { const u32x2* fr = (const u32x2*)(frow + (size_t)r * DM) + lane; const u32x2* xr = (const u32x2*)(xb + (size_t)r * DM) + lane; rnv[r] = rn[r];
#pragma unroll
        for (int j = 0; j < 4; ++j) { const u32x2 w = fr[64 * j]; f[r][j] = (f32x4){bflo(w.x), bfhi(w.x), bflo(w.y), bfhi(w.y)}; const u32x2 x = xr[64 * j]; v[r][j] = (f32x4){bflo(x.x), bfhi(x.x), bflo(x.y), bfhi(x.y)}; } }
    f32x4 g[4];
#pragma unroll
    for (int j = 0; j < 4; ++j) g[j] = ((const f32x4*)gpost + lane)[64 * j];
#pragma unroll
    for (int r = 0; r < R; ++r) { s[r] = 0.f;
#pragma unroll
        for (int j = 0; j < 4; ++j) s[r] += (f[r][j].x * f[r][j].x + f[r][j].y * f[r][j].y) + (f[r][j].z * f[r][j].z + f[r][j].w * f[r][j].w); }
#pragma unroll
    for (int o = 1; o < 64; o <<= 1) {
#pragma unroll
        for (int r = 0; r < R; ++r) s[r] += __shfl_xor(s[r], o); }
    float s2[R];
#pragma unroll
    for (int r = 0; r < R; ++r) { const float rf = c * rsqrtf(s[r] * (1.f / DM) + EPS); s2[r] = 0.f;
#pragma unroll
        for (int j = 0; j < 4; ++j) { v[r][j] = v[r][j] * rnv[r] + f[r][j] * rf * g[j]; s2[r] += (v[r][j].x * v[r][j].x + v[r][j].y * v[r][j].y) + (v[r][j].z * v[r][j].z + v[r][j].w * v[r][j].w); }
        if (FINAL) { f32x4* yo = (f32x4*)(yout + (size_t)r * DM) + lane;
#pragma unroll
            for (int j = 0; j < 4; ++j) yo[64 * j] = v[r][j]; } }
    if (!FINAL) {
#pragma unroll
        for (int o = 1; o < 64; o <<= 1) {
#pragma unroll
            for (int r = 0; r < R; ++r) s2[r] += __shfl_xor(s2[r], o); }
#pragma unroll
        for (int r = 0; r < R; ++r) { const float ms = s2[r] * (1.f / DM) + EPS; const float rstd = rsqrtf(ms); u32x2* o8 = (u32x2*)(xb + (size_t)r * DM) + lane;
#pragma unroll
            for (int j = 0; j < 4; ++j) { u32x2 w; w.x = pk2(v[r][j].x * rstd, v[r][j].y * rstd); w.y = pk2(v[r][j].z * rstd, v[r][j].w * rstd); o8[64 * j] = w; }
            if (lane == 0) rn[r] = ms * rstd; }
    }
}

constexpr int XS_OFF = 0, XS_P = 544;
constexpr int BS_OFF = 34816, RB_P = 288;
constexpr int CS_OFF = 53248;
constexpr int S_OFF = 71680, RC_P = 272;
constexpr int YS_OFF = 94208, YS_P = 528;
constexpr int TAB_OFF = 89088;
constexpr int MF_OFF = 94208;
static_assert(MF_OFF >= TAB_OFF + 4 * 1024 + 64 && MF_OFF + 24576 <= 131072, "ssd lds 2");
static_assert(YS_OFF + 64 * YS_P <= 131072 && S_OFF + 64 * RC_P <= TAB_OFF && TAB_OFF + 4 * 1024 + 64 <= 131072, "ssd lds");
typedef short s16x4 __attribute__((ext_vector_type(4)));
__device__ __forceinline__ bf16x8 tr_frag(const LAS unsigned char* p0, const LAS unsigned char* p1) {
    const s16x4 a = __builtin_amdgcn_ds_read_tr16_b64_v4i16((LAS s16x4*)p0), b = __builtin_amdgcn_ds_read_tr16_b64_v4i16((LAS s16x4*)p1);
    return __builtin_shufflevector(a, b, 0, 1, 2, 3, 4, 5, 6, 7);
}

__device__ __forceinline__ int crow(int reg, int h) { return (reg & 3) + 8 * (reg >> 2) + 4 * h; }
#define MFMA32(a, b, c) __builtin_amdgcn_mfma_f32_32x32x16_bf16((a), (b), (c), 0, 0, 0)

__device__ __forceinline__ void ssd_item(LAS unsigned char* lds, const bf16_t* XBC, bf16_t* ZY, const float* DT, int row0, int T, int g,
                                         const float* h0  , const float* convc  , float* ssm_out  ,
                                         const float* conv_w, const float* conv_b, const float* a_log, const float* d_skip) {
    const int tid = threadIdx.x, lane = tid & 63, wave = __builtin_amdgcn_readfirstlane(tid >> 6);
    const int hh = wave >> 1, ph = wave & 1, half = lane >> 5, r31 = lane & 31;
    const int cq = tid & 127, rq = wave >> 1, lc = 4 * cq;
    const int seg = lc < 256 ? 0 : (lc < 384 ? 1 : 2);
    const int col0 = seg == 0 ? 256 * g + lc : (seg == 1 ? 2048 + 128 * g + (lc - 256) : 3072 + 128 * g + (lc - 384));
    const int pitchA = seg == 0 ? XS_P : RB_P;
    LAS unsigned char* const pRM = lds + (seg == 0 ? XS_OFF + lc * 2 : (seg == 1 ? BS_OFF + (lc - 256) * 2 : CS_OFF + (lc - 384) * 2)) + 16 * rq * pitchA;
    const float a_h = -__expf(a_log[4 * g + hh]);
    const float a_scan = -__expf(a_log[4 * g + (wave & 3)]);
    const float Dh = d_skip[4 * g + hh];
    (void)a_h;
    f32x16 hT[4];
    {
        const float* hb = h0 ? h0 + ((size_t)hh * 64 + 32 * ph + r31) * 128 + 4 * half : nullptr;
#pragma unroll
        for (int nb = 0; nb < 4; ++nb)
#pragma unroll
            for (int q = 0; q < 4; ++q) { f32x4 v = {0.f, 0.f, 0.f, 0.f}; if (hb) v = *(const f32x4*)(hb + 32 * nb + 8 * q);
                hT[nb][4 * q] = v[0]; hT[nb][4 * q + 1] = v[1]; hT[nb][4 * q + 2] = v[2]; hT[nb][4 * q + 3] = v[3]; }
    }
    LAS unsigned char* const pYs = lds + YS_OFF + (4 * half) * YS_P + (64 * hh + 32 * ph + r31) * 2;
    const LAS unsigned char* const pCs = lds + CS_OFF + r31 * RB_P + (4 * half) * 2;
    const int trq = (lane & 15) >> 2, trp = lane & 3, trb = (lane >> 4) & 1;
    const LAS unsigned char* const pXf = lds + XS_OFF + (8 * half + trq) * XS_P + (64 * hh + 32 * ph + 16 * trb + 4 * trp) * 2;
    const LAS unsigned char* const pBt = lds + BS_OFF + (8 * half + trq) * RB_P + (16 * trb + 4 * trp) * 2;
    const LAS unsigned char* const pS = lds + S_OFF + r31 * RC_P + (8 * half) * 4;
    LAS float* dtL = (LAS float*)(lds + TAB_OFF); LAS float* acsL = dtL + 256; LAS float* eacsL = dtL + 512; LAS float* wL = dtL + 768; LAS float* eAL = dtL + 1024;
    const int nch = (T + 63) >> 6;
    {
        const int tA = 0, vA = T < 64 ? T : 64;
        u32x2 raw[19];
            const int rb = 16 * rq;
#pragma unroll
            for (int j = 0; j < 19; ++j) { const int t = tA + rb - 3 + j;
                raw[j] = (u32x2){0u, 0u};
                if (t >= 0 && t < T) raw[j] = *(const u32x2*)(XBC + (size_t)(row0 + t) * CONVD + col0); }
            const float dtvA = (wave < 4 && lane < vA) ? DT[(size_t)(row0 + tA + lane) * 32 + 4 * g + (wave & 3)] : 0.f;
            f32x4 cw[4];
#pragma unroll
            for (int k = 0; k < 4; ++k) cw[k] = *(const f32x4*)(conv_w + k * CONVD + col0);
            const f32x4 cb = *(const f32x4*)(conv_b + col0);
#pragma unroll
            for (int r = 0; r < 16; r += 2) {
                f32x4 xw5[5];
#pragma unroll
                for (int j = 0; j < 5; ++j) { const int t = tA + rb - 3 + r + j; const u32x2 w = raw[r + j];
                    xw5[j] = (f32x4){bflo(w.x), bfhi(w.x), bflo(w.y), bfhi(w.y)};
                    if (t < 0 && convc) xw5[j] = *(const f32x4*)(convc + (3 + t) * CONVD + col0); }
                f32x4 o0 = cb + cw[0] * xw5[0] + cw[1] * xw5[1] + cw[2] * xw5[2] + cw[3] * xw5[3];
                f32x4 o1 = cb + cw[0] * xw5[1] + cw[1] * xw5[2] + cw[2] * xw5[3] + cw[3] * xw5[4];
                o0 = silu4(o0); o1 = silu4(o1);
                if (vA < 64) { if (rb + r >= vA) o0 = (f32x4){0.f, 0.f, 0.f, 0.f}; if (rb + r + 1 >= vA) o1 = (f32x4){0.f, 0.f, 0.f, 0.f}; }
                *(LAS u32x2*)(pRM + r * pitchA) = (u32x2){pk2(o0[0], o0[1]), pk2(o0[2], o0[3])}; *(LAS u32x2*)(pRM + (r + 1) * pitchA) = (u32x2){pk2(o1[0], o1[1]), pk2(o1[2], o1[3])};
                __builtin_amdgcn_sched_barrier(0);
            }
        if (wave < 4) {
            const float dtv = dtvA;
            float cs = dtv;
#pragma unroll
            for (int o = 1; o < 64; o <<= 1) { const float t = __shfl_up(cs, o); if (lane >= o) cs += t; }
            const float acs = a_scan * cs; const float tot = __shfl(acs, 63);
            dtL[wave * 64 + lane] = dtv; acsL[wave * 64 + lane] = acs; eacsL[wave * 64 + lane] = __expf(acs); wL[wave * 64 + lane] = dtv * __expf(tot - acs);
            if (lane == 0) eAL[wave] = __expf(tot);
        }
    }
    __syncthreads();
    for (int c = 0; c < nch; ++c) {
        const int t0 = 64 * c; const int valid = (T - t0) < 64 ? (T - t0) : 64;
        int tl_ = threadIdx.x; asm volatile("" : "+v"(tl_));
        const int tid = tl_, lane = tid & 63, half = lane >> 5, r31 = lane & 31;
        const int cq = tid & 127, lc = 4 * cq;
        const int seg = lc < 256 ? 0 : (lc < 384 ? 1 : 2);
        const int col0 = seg == 0 ? 256 * g + lc : (seg == 1 ? 2048 + 128 * g + (lc - 256) : 3072 + 128 * g + (lc - 384));
        const int pitchA = seg == 0 ? XS_P : RB_P;
        LAS unsigned char* const pRM = lds + (seg == 0 ? XS_OFF + lc * 2 : (seg == 1 ? BS_OFF + (lc - 256) * 2 : CS_OFF + (lc - 384) * 2)) + 16 * rq * pitchA;
        LAS unsigned char* const pYs = lds + YS_OFF + (4 * half) * YS_P + (64 * hh + 32 * ph + r31) * 2;
        const LAS unsigned char* const pCs = lds + CS_OFF + r31 * RB_P + (4 * half) * 2;
        const int trq = (lane & 15) >> 2, trp = lane & 3, trb = (lane >> 4) & 1;
        const LAS unsigned char* const pXf = lds + XS_OFF + (8 * half + trq) * XS_P + (64 * hh + 32 * ph + 16 * trb + 4 * trp) * 2;
        const LAS unsigned char* const pBt = lds + BS_OFF + (8 * half + trq) * RB_P + (16 * trb + 4 * trp) * 2;
        const LAS unsigned char* const pS = lds + S_OFF + r31 * RC_P + (8 * half) * 4;
        {
            const int fr = lane & 15, fq = lane >> 4;
#pragma unroll
            for (int tt = 0; tt < 2; ++tt) { const int t = 2 * wave + tt, lt = t >> 2, st = t & 3;
                {
                    f32x4 sacc = {0.f, 0.f, 0.f, 0.f};
#pragma unroll
                    for (int ks = 0; ks < 4; ++ks) {
                        const bf16x8 af = *(const LAS bf16x8*)(lds + CS_OFF + (16 * lt + fr) * RB_P + (32 * ks + 8 * fq) * 2);
                        const bf16x8 bfr = *(const LAS bf16x8*)(lds + BS_OFF + (16 * st + fr) * RB_P + (32 * ks + 8 * fq) * 2);
                        sacc = __builtin_amdgcn_mfma_f32_16x16x32_bf16(af, bfr, sacc, 0, 0, 0);
                    }
#pragma unroll
                    for (int j = 0; j < 4; ++j) *(LAS float*)(lds + S_OFF + (16 * lt + 4 * fq + j) * RC_P + (16 * st + fr) * 4) = sacc[j];
                }
            }
        }
        __syncthreads();
#pragma unroll 1
        for (int it3 = 0; it3 < 3; ++it3) {
            const int fi = ph + 2 * it3;
            const int lt = fi >= 2 ? 1 : 0, ks = lt ? fi - 2 : fi;
            const int l = 32 * lt + r31; const float acs_l = acsL[hh * 64 + l];
            const int s0 = 16 * ks + 8 * half;
            const LAS float* sp = (const LAS float*)(pS + (32 * lt) * RC_P + (16 * ks) * 4);
            const f32x4 sv0 = *(const LAS f32x4*)sp, sv1 = *(const LAS f32x4*)(sp + 4);
            const f32x4 as0 = *(const LAS f32x4*)(acsL + hh * 64 + s0), as1 = *(const LAS f32x4*)(acsL + hh * 64 + s0 + 4);
            const f32x4 d0 = *(const LAS f32x4*)(dtL + hh * 64 + s0), d1 = *(const LAS f32x4*)(dtL + hh * 64 + s0 + 4);
            float mv[8];
            if (lt == 1 && ks < 2) {
#pragma unroll
                for (int j = 0; j < 8; ++j) { const float sv = j < 4 ? sv0[j & 3] : sv1[j & 3], as = j < 4 ? as0[j & 3] : as1[j & 3], dd = j < 4 ? d0[j & 3] : d1[j & 3];
                    mv[j] = sv * __expf(acs_l - as) * dd; }
            } else {
                const float dl0 = (float)(l - s0);
#pragma unroll
                for (int j = 0; j < 8; ++j) { const float sv = j < 4 ? sv0[j & 3] : sv1[j & 3], as = j < 4 ? as0[j & 3] : as1[j & 3], dd = j < 4 ? d0[j & 3] : d1[j & 3];
                    const float dl = dl0 - (float)j;
                    const float maskf = fminf(fmaxf(dl + 1.f, 0.f), 1.f);
                    const float diagf = fmaxf(1.f - fabsf(dl), 0.f);
                    mv[j] = sv * __expf(fminf(acs_l - as, 0.f)) * dd * maskf + Dh * diagf; }
            }
            u32x4 ap; ap.x = pk2(mv[0], mv[1]); ap.y = pk2(mv[2], mv[3]); ap.z = pk2(mv[4], mv[5]); ap.w = pk2(mv[6], mv[7]);
            *(LAS u32x4*)(lds + MF_OFF + ((hh * 6 + fi) * 64 + lane) * 16) = ap;
        }
        f32x16 y[2];
#pragma unroll
        for (int lt = 0; lt < 2; ++lt)
#pragma unroll
            for (int i = 0; i < 16; ++i) y[lt][i] = 0.f;
#pragma unroll
        for (int nb = 0; nb < 4; ++nb)
#pragma unroll
            for (int s = 0; s < 2; ++s) {
                u32x4 bp; bp.x = pk2(hT[nb][8 * s + 0], hT[nb][8 * s + 1]); bp.y = pk2(hT[nb][8 * s + 2], hT[nb][8 * s + 3]); bp.z = pk2(hT[nb][8 * s + 4], hT[nb][8 * s + 5]); bp.w = pk2(hT[nb][8 * s + 6], hT[nb][8 * s + 7]);
                const bf16x8 bfrag = __builtin_bit_cast(bf16x8, bp);
#pragma unroll
                for (int lt = 0; lt < 2; ++lt) {
                    const LAS unsigned char* cp = pCs + (32 * lt) * RB_P + (32 * nb + 16 * s) * 2;
                    const u32x2 lo = *(const LAS u32x2*)cp, hi = *(const LAS u32x2*)(cp + 16);
                    const bf16x8 afrag = __builtin_bit_cast(bf16x8, (u32x4){lo.x, lo.y, hi.x, hi.y});
                    y[lt] = MFMA32(afrag, bfrag, y[lt]);
                }
                __builtin_amdgcn_sched_barrier(0);
            }
#pragma unroll
        for (int lt = 0; lt < 2; ++lt)
#pragma unroll
            for (int q = 0; q < 4; ++q) { const f32x4 e = *(const LAS f32x4*)(eacsL + hh * 64 + 32 * lt + 8 * q + 4 * half);
#pragma unroll
                for (int j = 0; j < 4; ++j) y[lt][4 * q + j] *= e[j]; }
        bf16x8 xf[4];
#pragma unroll
        for (int ks = 0; ks < 4; ++ks) xf[ks] = tr_frag(pXf + (16 * ks) * XS_P, pXf + (16 * ks + 4) * XS_P);
        __syncthreads();
#pragma unroll
        for (int fi = 0; fi < 6; ++fi) { const int lt = fi >= 2 ? 1 : 0, ks = lt ? fi - 2 : fi;
            const bf16x8 mf = *(const LAS bf16x8*)(lds + MF_OFF + ((hh * 6 + fi) * 64 + lane) * 16);
            y[lt] = MFMA32(mf, xf[ks], y[lt]); }
        __syncthreads();
#pragma unroll
        for (int lt = 0; lt < 2; ++lt)
#pragma unroll
            for (int i = 0; i < 16; ++i)
                *(LAS bf16_t*)(pYs + (32 * lt + (i & 3) + 8 * (i >> 2)) * YS_P) = (bf16_t)(pk2(y[lt][i], 0.f) & 0xffffu);
        const int nl = tid >> 3, npart = tid & 7;
        u32x4 zr[4];
        {
            const bf16_t* zp = ZY + (size_t)(row0 + t0 + (nl < valid ? nl : 0)) * DINNER + 256 * g + 32 * npart;
#pragma unroll
            for (int q = 0; q < 4; ++q) zr[q] = *(const u32x4*)(zp + 8 * q);
        }
        {
            const float eA = eAL[hh];
#pragma unroll
            for (int nb = 0; nb < 4; ++nb)
#pragma unroll
                for (int i = 0; i < 16; ++i) hT[nb][i] *= eA;
            bf16x8 xw[4];
#pragma unroll
            for (int ks = 0; ks < 4; ++ks) { const u32x4 xr = __builtin_bit_cast(u32x4, xf[ks]);
                const f32x4 w0 = *(const LAS f32x4*)(wL + hh * 64 + 16 * ks + 8 * half), w1 = *(const LAS f32x4*)(wL + hh * 64 + 16 * ks + 8 * half + 4);
                u32x4 o; o.x = pk2(bflo(xr.x) * w0[0], bfhi(xr.x) * w0[1]); o.y = pk2(bflo(xr.y) * w0[2], bfhi(xr.y) * w0[3]); o.z = pk2(bflo(xr.z) * w1[0], bfhi(xr.z) * w1[1]); o.w = pk2(bflo(xr.w) * w1[2], bfhi(xr.w) * w1[3]);
                xw[ks] = __builtin_bit_cast(bf16x8, o); }
#pragma unroll
            for (int nb = 0; nb < 4; ++nb)
#pragma unroll
                for (int ks = 0; ks < 4; ++ks) {
                    const bf16x8 af = tr_frag(pBt + (16 * ks) * RB_P + 64 * nb, pBt + (16 * ks + 4) * RB_P + 64 * nb);
                    hT[nb] = MFMA32(af, xw[ks], hT[nb]);
                }
        }
        __syncthreads();
        const bool nxtc = c + 1 < nch; const int tA = t0 + 64, vA = (T - tA) < 64 ? (T - tA) : 64; const int rb = 16 * rq;
        u32x2 raw[19]; float dtvA = 0.f;
        if (nxtc) {
#pragma unroll
            for (int j = 0; j < 19; ++j) { const int t = tA + rb - 3 + j;
                raw[j] = (u32x2){0u, 0u};
                if (t >= 0 && t < T) raw[j] = *(const u32x2*)(XBC + (size_t)(row0 + t) * CONVD + col0); }
            if (wave < 4 && lane < vA) dtvA = DT[(size_t)(row0 + tA + lane) * 32 + 4 * g + (wave & 3)];
        }
        __builtin_amdgcn_sched_barrier(0);
        {
            float gv[32]; float ss = 0.f;
#pragma unroll
            for (int q = 0; q < 4; ++q) { const u32x4 yv = *(const LAS u32x4*)(lds + YS_OFF + nl * YS_P + npart * 64 + q * 16);
                const f32x4 za = {bflo(zr[q].x), bfhi(zr[q].x), bflo(zr[q].y), bfhi(zr[q].y)}, zb = {bflo(zr[q].z), bfhi(zr[q].z), bflo(zr[q].w), bfhi(zr[q].w)};
                const f32x4 ya = {bflo(yv.x), bfhi(yv.x), bflo(yv.y), bfhi(yv.y)}, yb = {bflo(yv.z), bfhi(yv.z), bflo(yv.w), bfhi(yv.w)};
                const f32x4 ga = ya * pg8::silu4(za), gb = yb * pg8::silu4(zb);
#pragma unroll
                for (int e = 0; e < 4; ++e) { gv[8 * q + e] = ga[e]; gv[8 * q + 4 + e] = gb[e]; ss += ga[e] * ga[e] + gb[e] * gb[e]; } }
            ss += __shfl_xor(ss, 1); ss += __shfl_xor(ss, 2); ss += __shfl_xor(ss, 4);
            const float rstd = rsqrtf(ss * (1.f / 256.f) + EPS);
            if (nl < valid) {
                bf16_t* op = ZY + (size_t)(row0 + t0 + nl) * DINNER + 256 * g + 32 * npart;
#pragma unroll
                for (int q = 0; q < 4; ++q) { u32x4 o; o.x = pk2(gv[8 * q] * rstd, gv[8 * q + 1] * rstd); o.y = pk2(gv[8 * q + 2] * rstd, gv[8 * q + 3] * rstd); o.z = pk2(gv[8 * q + 4] * rstd, gv[8 * q + 5] * rstd); o.w = pk2(gv[8 * q + 6] * rstd, gv[8 * q + 7] * rstd);
                    *(u32x4*)(op + 8 * q) = o; }
            }
        }
        __builtin_amdgcn_sched_barrier(0);
        if (nxtc) {
            f32x4 cw[4];
#pragma unroll
            for (int k = 0; k < 4; ++k) cw[k] = *(const f32x4*)(conv_w + k * CONVD + col0);
            const f32x4 cb = *(const f32x4*)(conv_b + col0);
#pragma unroll
            for (int r = 0; r < 16; r += 2) {
                f32x4 xw5[5];
#pragma unroll
                for (int j = 0; j < 5; ++j) { const int t = tA + rb - 3 + r + j; const u32x2 w = raw[r + j];
                    xw5[j] = (f32x4){bflo(w.x), bfhi(w.x), bflo(w.y), bfhi(w.y)};
                    if (t < 0 && convc) xw5[j] = *(const f32x4*)(convc + (3 + t) * CONVD + col0); }
                f32x4 o0 = cb + cw[0] * xw5[0] + cw[1] * xw5[1] + cw[2] * xw5[2] + cw[3] * xw5[3];
                f32x4 o1 = cb + cw[0] * xw5[1] + cw[1] * xw5[2] + cw[2] * xw5[3] + cw[3] * xw5[4];
                o0 = silu4(o0); o1 = silu4(o1);
                if (vA < 64) { if (rb + r >= vA) o0 = (f32x4){0.f, 0.f, 0.f, 0.f}; if (rb + r + 1 >= vA) o1 = (f32x4){0.f, 0.f, 0.f, 0.f}; }
                *(LAS u32x2*)(pRM + r * pitchA) = (u32x2){pk2(o0[0], o0[1]), pk2(o0[2], o0[3])}; *(LAS u32x2*)(pRM + (r + 1) * pitchA) = (u32x2){pk2(o1[0], o1[1]), pk2(o1[2], o1[3])};
                __builtin_amdgcn_sched_barrier(0);
            }
        if (wave < 4) {
            const float dtv = dtvA;
            float cs = dtv;
#pragma unroll
            for (int o = 1; o < 64; o <<= 1) { const float t = __shfl_up(cs, o); if (lane >= o) cs += t; }
            const float acs = a_scan * cs; const float tot = __shfl(acs, 63);
            dtL[wave * 64 + lane] = dtv; acsL[wave * 64 + lane] = acs; eacsL[wave * 64 + lane] = __expf(acs); wL[wave * 64 + lane] = dtv * __expf(tot - acs);
            if (lane == 0) eAL[wave] = __expf(tot);
        }
        }
        __syncthreads();
    }
    {
        float* sb = ssm_out + ((size_t)hh * 64 + 32 * ph + r31) * 128 + 4 * half;
#pragma unroll
        for (int nb = 0; nb < 4; ++nb)
#pragma unroll
            for (int q = 0; q < 4; ++q) *(f32x4*)(sb + 32 * nb + 8 * q) = (f32x4){hT[nb][4 * q], hT[nb][4 * q + 1], hT[nb][4 * q + 2], hT[nb][4 * q + 3]};
    }
}

__device__ __forceinline__ void load8(const bf16_t* p, float (&v)[8]) { const u32x4 w = *(const u32x4*)p; v[0] = bflo(w.x); v[1] = bfhi(w.x); v[2] = bflo(w.y); v[3] = bfhi(w.y); v[4] = bflo(w.z); v[5] = bfhi(w.z); v[6] = bflo(w.w); v[7] = bfhi(w.w); }
__device__ __forceinline__ void pool_task(const bf16_t* U, bf16_t* PL, int row0, int T, int t0, int hsel, int pos0, const float* cache  , int lane) {
    const int o = hsel * 64 + lane, col = 8 * o, gi = o >> 5, k = 2 << gi;
    float ws[8];
#pragma unroll
    for (int i = 0; i < 8; ++i) ws[i] = 0.f;
    for (int j = 1; j < k; ++j) { const int t = t0 - j; float v[8];
        if (t >= 0) { load8(U + (size_t)(row0 + t) * DM + col, v); }
        else if (cache) { const f32x4 a = *(const f32x4*)(cache + (15 + t) * DM + col), b = *(const f32x4*)(cache + (15 + t) * DM + col + 4); v[0] = a[0]; v[1] = a[1]; v[2] = a[2]; v[3] = a[3]; v[4] = b[0]; v[5] = b[1]; v[6] = b[2]; v[7] = b[3]; }
        else {
#pragma unroll
            for (int i = 0; i < 8; ++i) v[i] = 0.f; }
#pragma unroll
        for (int i = 0; i < 8; ++i) ws[i] += v[i]; }
    const int nr = (T - t0) < 64 ? (T - t0) : 64;
    for (int r0 = 0; r0 < nr; r0 += 8) {
        u32x4 cu[8], ol[8];
#pragma unroll
        for (int r = 0; r < 8; ++r) { const int t = t0 + r0 + r, to = t - k + 1;
            cu[r] = *(const u32x4*)(U + (size_t)(row0 + t) * DM + col);
            ol[r] = (u32x4){0u, 0u, 0u, 0u};
            if (to >= 0) ol[r] = *(const u32x4*)(U + (size_t)(row0 + to) * DM + col); }
#pragma unroll
        for (int r = 0; r < 8; ++r) { const int t = t0 + r0 + r, to = t - k + 1;
            float cur[8] = {bflo(cu[r].x), bfhi(cu[r].x), bflo(cu[r].y), bfhi(cu[r].y), bflo(cu[r].z), bfhi(cu[r].z), bflo(cu[r].w), bfhi(cu[r].w)};
            float old[8] = {bflo(ol[r].x), bfhi(ol[r].x), bflo(ol[r].y), bfhi(ol[r].y), bflo(ol[r].z), bfhi(ol[r].z), bflo(ol[r].w), bfhi(ol[r].w)};
            if (to < 0 && cache) { const f32x4 a = *(const f32x4*)(cache + (15 + to) * DM + col), b = *(const f32x4*)(cache + (15 + to) * DM + col + 4); old[0] = a[0]; old[1] = a[1]; old[2] = a[2]; old[3] = a[3]; old[4] = b[0]; old[5] = b[1]; old[6] = b[2]; old[7] = b[3]; }
            const int pc = pos0 + t + 1; const float inv = 1.0f / (float)(pc < k ? pc : k);
            float pv[8];
#pragma unroll
            for (int i = 0; i < 8; ++i) { ws[i] += cur[i]; pv[i] = ws[i] * inv - cur[i]; ws[i] -= old[i]; }
            u32x4 w; w.x = pk2(pv[0], pv[1]); w.y = pk2(pv[2], pv[3]); w.z = pk2(pv[4], pv[5]); w.w = pk2(pv[6], pv[7]);
            *(u32x4*)(PL + (size_t)(row0 + t) * DM + col) = w; }
    }
}

enum { SM_SWIGLU = 0, SM_BF16 = 1, SM_WIN1 = 2, SM_WIN2 = 3, SM_GATE0 = 4, SM_GATE1 = 5 };
constexpr int SMR_P = 36, SMT_OFF = 8 * 32 * SMR_P * 4, SMT_P = 33;
template <int MODE>
__device__ __forceinline__ void small_gemm(LAS unsigned char* lds, const bf16_t* A, const bf16_t* Bt, int N, int K,
                                           bf16_t* O0, bf16_t* O1, float* OF, const float* bias) {
    int tid_ = threadIdx.x; asm volatile("" : "+v"(tid_));
    const int tid = tid_, lane = tid & 63, wave = __builtin_amdgcn_readfirstlane(tid >> 6), r31 = lane & 31, half = lane >> 5;
    const int ntiles = 4 * (N >> 5), ksl = K >> 3, nsteps = ksl >> 4;
    LAS float* red = (LAS float*)lds; LAS float* tile = (LAS float*)(lds + SMT_OFF);
    for (int t = blockIdx.x; t < ntiles; t += gridDim.x) {
        const int mq = t & 3, n0 = (t >> 2) << 5;
        const bf16_t* bp = Bt + (size_t)(n0 + r31) * K + wave * ksl + 8 * half;
        const bf16_t* ap = A + (size_t)(32 * mq + r31) * K + wave * ksl + 8 * half;
        f32x16 acc;
#pragma unroll
        for (int i = 0; i < 16; ++i) acc[i] = 0.f;
#pragma unroll 8
        for (int s = 0; s < nsteps; ++s) {
            const bf16x8 bfr = *(const bf16x8*)(bp + 16 * s), afr = *(const bf16x8*)(ap + 16 * s);
            acc = MFMA32(bfr, afr, acc);
        }
#pragma unroll
        for (int q = 0; q < 4; ++q) *(LAS f32x4*)(red + (wave * 32 + r31) * SMR_P + 8 * q + 4 * half) = (f32x4){acc[4 * q], acc[4 * q + 1], acc[4 * q + 2], acc[4 * q + 3]};
        __syncthreads();
        { const int m = tid >> 4, n = 2 * (tid & 15); float s0 = 0.f, s1 = 0.f;
#pragma unroll
          for (int w = 0; w < 8; ++w) { s0 += red[(w * 32 + m) * SMR_P + n]; s1 += red[(w * 32 + m) * SMR_P + n + 1]; }
          tile[m * SMT_P + n] = s0; tile[m * SMT_P + n + 1] = s1; }
        __syncthreads();
        {
            const int m = tid >> 4, j = tid & 15, n = 2 * j; const size_t row = (size_t)MP + 32 * mq + m;
            if (MODE == SM_SWIGLU) {
                const int pn = n0 >> 8, c0 = n0 & 255, bj = c0 >> 7, wc = (c0 >> 5) & 3;
                const int h = 128 * pn + 32 * wc + 8 * (j >> 2) + 4 * bj + (j & 3);
                const float g = tile[m * SMT_P + j], u = tile[m * SMT_P + 16 + j];
                O0[row * DFF + h] = (bf16_t)(pk2(fast_silu(g) * u, 0.f) & 0xffffu);
            } else {
                float v0 = tile[m * SMT_P + n], v1 = tile[m * SMT_P + n + 1]; const int np = n0 + n;
                if (MODE == SM_BF16) { *(unsigned*)(O0 + row * DM + np) = pk2(v0, v1); }
                if (MODE == SM_WIN1) {
                    if (np < 2048) *(unsigned*)(O0 + row * 2048 + np) = pk2(v0, v1);
                    else if (np < 6144) *(unsigned*)(O1 + row * 4096 + (np - 2048)) = pk2(v0, v1);
                    else { const int c = np - 6144; v0 += bias[c]; v1 += bias[c + 1];
                        OF[row * 32 + c] = fmaxf(v0, 0.f) + log1pf(expf(-fabsf(v0))); OF[row * 32 + c + 1] = fmaxf(v1, 0.f) + log1pf(expf(-fabsf(v1))); }
                }
                if (MODE == SM_WIN2) { const int tt = np >> 10; if (tt) { v0 = fast_sigmoid(v0); v1 = fast_sigmoid(v1); }
                    *(unsigned*)(O0 + (size_t)tt * MT * 1024 + row * DM + (np & 1023)) = pk2(v0, v1); }
                if (MODE == SM_GATE0) { unsigned* p = (unsigned*)(O0 + row * DM + np); const unsigned g = *p; *p = pk2(bflo(g) * v0, bfhi(g) * v1); }
                if (MODE == SM_GATE1) { unsigned* p = (unsigned*)(O0 + row * DM + np); const unsigned g = *p, tt = *(const unsigned*)(O1 + row * DM + np);
                    *p = pk2(bflo(tt) + bflo(g) * v0, bfhi(tt) + bfhi(g) * v1); }
            }
        }
    }
    __syncthreads();
}


constexpr int SM16_P = 20;
template <int MODE>
__device__ __forceinline__ void small_gemm16(LAS unsigned char* lds, const bf16_t* A, const bf16_t* Bt, int K, bf16_t* O0, const bf16_t* O1) {
    int tid_ = threadIdx.x; asm volatile("" : "+v"(tid_));
    const int tid = tid_, lane = tid & 63, wave = __builtin_amdgcn_readfirstlane(tid >> 6), r15 = lane & 15, kq = lane >> 4;
    const int ksl = K >> 3, nsteps = ksl >> 5;
    LAS float* red = (LAS float*)lds;
    for (int t = blockIdx.x; t < 256; t += gridDim.x) {
        const int mq = t & 3, n0 = (t >> 2) << 4;
        const bf16_t* bp = Bt + (size_t)(n0 + r15) * K + wave * ksl + 8 * kq;
        const bf16_t* ap = A + (size_t)(32 * mq + r15) * K + wave * ksl + 8 * kq;
        f32x4 acc0 = {0.f, 0.f, 0.f, 0.f}, acc1 = {0.f, 0.f, 0.f, 0.f};
#pragma unroll 4
        for (int s = 0; s < nsteps; ++s) {
            const bf16x8 bfr = *(const bf16x8*)(bp + 32 * s), a0 = *(const bf16x8*)(ap + 32 * s), a1 = *(const bf16x8*)(ap + (size_t)16 * K + 32 * s);
            acc0 = __builtin_amdgcn_mfma_f32_16x16x32_bf16(bfr, a0, acc0, 0, 0, 0);
            acc1 = __builtin_amdgcn_mfma_f32_16x16x32_bf16(bfr, a1, acc1, 0, 0, 0);
        }
        *(LAS f32x4*)(red + (wave * 32 + r15) * SM16_P + 4 * kq) = acc0;
        *(LAS f32x4*)(red + (wave * 32 + 16 + r15) * SM16_P + 4 * kq) = acc1;
        __syncthreads();
        {
            const int m = tid >> 4, n = tid & 15; float v = 0.f;
#pragma unroll
            for (int w = 0; w < 8; ++w) v += red[(w * 32 + m) * SM16_P + n];
            const size_t idx = ((size_t)MP + 32 * mq + m) * DM + n0 + n;
            if (MODE == SM_BF16) O0[idx] = (bf16_t)(pk2(v, 0.f) & 0xffffu);
            if (MODE == SM_GATE0) O0[idx] = (bf16_t)(pk2(bflo((unsigned)O0[idx]) * v, 0.f) & 0xffffu);
            if (MODE == SM_GATE1) O0[idx] = (bf16_t)(pk2(bflo((unsigned)O1[idx]) + bflo((unsigned)O0[idx]) * v, 0.f) & 0xffffu);
        }
        __syncthreads();
    }
}

#define RLX_AGENT __ATOMIC_RELAXED, __HIP_MEMORY_SCOPE_AGENT
#define XB_TMO      128
#define XB_XCNT(j)  (256  + 64 * (j))
#define XB_XSUB(j)  (1280 + 64 * (j))
#define XB_XGEN(j)  (2304 + 64 * (j))
#define XB_TOP      3328
#define XB_TOPGEN   3392
#define XCD_BAR_WORDS 3456
#define XB_SPIN_CAP (1u << 18)

__device__ __forceinline__ unsigned xb_ld(unsigned* p)              { return __hip_atomic_load(p, __ATOMIC_RELAXED, __HIP_MEMORY_SCOPE_AGENT); }
__device__ __forceinline__ unsigned xb_add(unsigned* p, unsigned v) { return __hip_atomic_fetch_add(p, v, __ATOMIC_RELAXED, __HIP_MEMORY_SCOPE_AGENT); }
__device__ __forceinline__ unsigned xb_xcc_id() { return (unsigned)__builtin_amdgcn_s_getreg((3 << 11) | 20) & 0xFu; }
#define XB_SPIN(cond, bar) do { unsigned _sp = 0; while (cond) { __builtin_amdgcn_s_sleep(1); \
    if ((++_sp & 255u) == 0u) { if (xb_ld(&(bar)[XB_TMO])) break; if (_sp > XB_SPIN_CAP) { atomicAdd(&(bar)[XB_TMO], 1u); break; } } } } while (0)

struct XcdBarrier {
    unsigned* bar; unsigned x;
    volatile LAS unsigned* st;
};

__device__ __forceinline__ XcdBarrier xcd_barrier_post(unsigned* bar, volatile LAS unsigned* st) {
    XcdBarrier b; b.bar = bar; b.x = xb_xcc_id(); b.st = st;
    if (threadIdx.x == 0) (void)xb_add(&bar[XB_XCNT(b.x)], 1u);
    return b;
}
__device__ __forceinline__ void xcd_barrier_complete(unsigned* bar, unsigned x, unsigned& nloc, unsigned& nx) {
    const unsigned G = gridDim.x * gridDim.y * gridDim.z;
    unsigned sum, cnt, mine, sp = 0u;
    for (;;) {
        sum = 0u; cnt = 0u; mine = 0u;
#pragma unroll
        for (unsigned j = 0; j < 16; ++j) { const unsigned c = xb_ld(&bar[XB_XCNT(j)]); sum += c; cnt += (c > 0u) ? 1u : 0u; mine = (j == x) ? c : mine; }
        if (sum == G) break;
        __builtin_amdgcn_s_sleep(1);
        if ((++sp & 255u) == 0u) { if (xb_ld(&bar[XB_TMO])) break; if (sp > XB_SPIN_CAP) { atomicAdd(&bar[XB_TMO], 1u); break; } }
    }
    nloc = mine > 0u ? mine : 1u; nx = cnt > 0u ? cnt : 1u;
}

__device__ __forceinline__ void xcd_barrier(const XcdBarrier& b) {
    asm volatile("s_waitcnt vmcnt(0)" ::: "memory");
    __syncthreads();
    if (threadIdx.x == 0) {
        unsigned* bar = b.bar;
        __builtin_amdgcn_s_waitcnt(0);
        unsigned nloc = b.st[0], nx = b.st[1];
        if (nloc == 0u) { xcd_barrier_complete(bar, b.x, nloc, nx); b.st[0] = nloc; b.st[1] = nx; }
        const unsigned old = xb_add(&bar[XB_XSUB(b.x)], 1u);
        const unsigned gen = old / nloc;
        if (old + 1u == (gen + 1u) * nloc) {
            __builtin_amdgcn_fence(__ATOMIC_RELEASE, "agent");
            asm volatile("s_waitcnt vmcnt(0)" ::: "memory");
            const unsigned og = xb_add(&bar[XB_TOP], 1u);
            const unsigned tg = og / nx;
            if (og + 1u == (tg + 1u) * nx) xb_add(&bar[XB_TOPGEN], 1u);
            else XB_SPIN(xb_ld(&bar[XB_TOPGEN]) == tg, bar);
            __builtin_amdgcn_fence(__ATOMIC_ACQUIRE, "agent");
            xb_add(&bar[XB_XGEN(b.x)], 1u);
            asm volatile("s_waitcnt vmcnt(0)" ::: "memory");
        } else {
            XB_SPIN(xb_ld(&bar[XB_XGEN(b.x)]) == gen, bar);
            __builtin_amdgcn_fence(__ATOMIC_ACQUIRE, "agent");
            asm volatile("s_waitcnt vmcnt(0)" ::: "memory");
        }
    }
    __syncthreads();
}

struct Params { const float* in[29]; float* out; unsigned char* ws; };
#define KAS __attribute__((address_space(4)))
__device__ __forceinline__ const KAS unsigned char* kargs() { const KAS unsigned char* p = (const KAS unsigned char*)__builtin_amdgcn_kernarg_segment_ptr(); asm volatile("" : "+s"(p)); return p; }
#define KIN(i) (*(const float* const KAS*)(kargs() + 8 * (i)))
#define KOUT (*(float* const KAS*)(kargs() + 232))
#define KWS (*(unsigned char* const KAS*)(kargs() + 240))
#define WSP(off) ((bf16_t*)(KWS + (off)))
constexpr int XB_ST_OFF = 131072 + 320;
#define XBAR_POST() do { (void)xcd_barrier_post((unsigned*)KWS, (volatile LAS unsigned*)(lds + XB_ST_OFF)); } while (0)
#define XBAR() do { XcdBarrier b_; b_.bar = (unsigned*)KWS; b_.x = xb_xcc_id(); b_.st = (volatile LAS unsigned*)(lds + XB_ST_OFF); xcd_barrier(b_); } while (0)

__global__ void __launch_bounds__(NTHREADS, 2) hybrid_fwd(Params Pdummy) {
    extern __shared__ __attribute__((aligned(16))) unsigned char lds_raw[];
    LAS unsigned char* lds = (LAS unsigned char*)lds_raw;
    cg::grid_group grid = cg::this_grid();
#define TID ((int)threadIdx.x)
#define LANE (TID & 63)
#define WAVE (__builtin_amdgcn_readfirstlane(TID >> 6))
#define GW ((int)blockIdx.x * NWAVES + WAVE)
#define NGW ((int)gridDim.x * NWAVES)
    constexpr size_t R2S = (size_t)MT * 1024 * 2;

    if (TID < 2) ((volatile LAS unsigned*)(lds + XB_ST_OFF))[TID] = 0u;
    if (blockIdx.x == 0) { unsigned* bw = (unsigned*)KWS; for (int i = TID; i < XCD_BAR_WORDS; i += NTHREADS) bw[i] = 0u; }
    {
        const int lane = LANE, wave = WAVE, gw = GW, ngw = NGW;
        LAS float* scr = (LAS float*)(lds + wave * 8448);
        constexpr int I_GU = 16 * 176, I_D = 44 * 32, I_IN = 16 * 296, I_PS = 32 * 32, I_O = 16 * 32;
        constexpr int NITEMS = 2 * (I_GU + I_D) + I_IN + I_PS + I_O;
        for (int it = gw; it < NITEMS; it += ngw) {
            int r = it;
            if (r < I_GU) { wt_item<1>(KIN(7), KIN(8), DFF, DM, KIN(5), WSP(WS_WGU1), 176, scr, r, lane); continue; } r -= I_GU;
            if (r < I_D) { wt_item<0>(KIN(9), nullptr, DM, DFF, nullptr, WSP(WS_WD1), 32, scr, r, lane); continue; } r -= I_D;
            if (r < I_IN) { wt_item<2>(KIN(12), nullptr, 9248, DM, KIN(10), WSP(WS_WIN), 296, scr, r, lane); continue; } r -= I_IN;
            if (r < I_PS) { wt_item<0>(KIN(19), nullptr, DM, DINNER, KIN(18), WSP(WS_WPS), 32, scr, r, lane); continue; } r -= I_PS;
            if (r < I_O) { wt_item<0>(KIN(23), nullptr, DM, DM, nullptr, WSP(WS_WOUT), 32, scr, r, lane); continue; } r -= I_O;
            if (r < I_GU) { wt_item<1>(KIN(26), KIN(27), DFF, DM, KIN(24), WSP(WS_WGU2), 176, scr, r, lane); continue; } r -= I_GU;
            wt_item<0>(KIN(28), nullptr, DM, DFF, nullptr, WSP(WS_WD2), 32, scr, r, lane);
        }
        { const float* mix = KIN(20); const float* sc = KIN(21); const float* wpp = KIN(22); bf16_t* wc = WSP(WS_WCOMB);
          for (int t = gw; t < 2048; t += ngw) wcomb_task(mix, sc, wpp, wc, t, lane); }
        { const float* xp = KIN(0); const float* xs = KIN(1); bf16_t* XB = WSP(WS_XB);
          for (int m = 4 * gw; m < MV; m += 4 * ngw) norm_rows_to_bf16<4>(m < MP ? xp + (size_t)m * DM : xs + (size_t)(m - MP) * DM, XB + (size_t)m * DM, (float*)(KWS + WS_RN) + m, lane); }
    }
    grid.sync();
    XBAR_POST();
    small_gemm<SM_SWIGLU>(lds, WSP(WS_XB) + (size_t)MP * DM, WSP(WS_WGU1), 2 * DFF, DM, WSP(WS_R2), nullptr, nullptr, nullptr);
    { pg8::Gemm g{WSP(WS_XB), WSP(WS_WGU1), MP, 2 * DFF, DM}; pg8::StaticOrder S; S.init(MP, 2 * DFF, gridDim.x, blockIdx.x); pg8::EpiSwiglu E{WSP(WS_R2), DFF};
      pg8::gemm_phase<pg8::EpiSwiglu, pg8::StaticOrder, true, true>(lds, g, S, E); }
    XBAR();
    small_gemm16<SM_BF16>(lds, WSP(WS_R2) + (size_t)MP * DFF, WSP(WS_WD1), DFF, WSP(WS_R1), nullptr);
    { pg8::Gemm g{WSP(WS_R2), WSP(WS_WD1), MP, DM, DFF, 1}; pg8::StaticOrder S; S.init(MP, DM, gridDim.x, blockIdx.x); pg8::EpiBf16 E{WSP(WS_R1), DM};
      pg8::gemm_phase<pg8::EpiBf16, pg8::StaticOrder, true, true>(lds, g, S, E); }
    XBAR();
    { const int lane = LANE, gw = GW, ngw = NGW; const float* gp = KIN(6); const bf16_t* F = WSP(WS_R1); bf16_t* XB = WSP(WS_XB); float* RN = (float*)(KWS + WS_RN);
      for (int m = 4 * gw; m < MV; m += 4 * ngw) post_rows2<4, false>(XB + (size_t)m * DM, RN + m, F + (size_t)m * DM, gp, 0.5f, nullptr, lane); }
    XBAR();
    small_gemm<SM_WIN1>(lds, WSP(WS_XB) + (size_t)MP * DM, WSP(WS_WIN), 6176, DM, WSP(WS_R1), WSP(WS_R2), (float*)(KWS + WS_DT), KIN(15));
    { pg8::Gemm g{WSP(WS_XB), WSP(WS_WIN), MP, NWIN1, DM}; pg8::StaticOrder S; S.init(MP, NWIN1, gridDim.x, blockIdx.x); pg8::EpiWin1 E{WSP(WS_R1), WSP(WS_R2), (float*)(KWS + WS_DT), KIN(15)};
      pg8::gemm_phase<pg8::EpiWin1, pg8::StaticOrder, true, true>(lds, g, S, E); }
    XBAR();
    {
        const int G = gridDim.x, bid = blockIdx.x;
        const bf16_t* XBC = WSP(WS_R2); bf16_t* ZY = WSP(WS_R1); const float* DT = (const float*)(KWS + WS_DT); float* out = KOUT;
        for (int it = bid; it < 256 + 64; it += G) {
            const bool smp = it >= 256; const int b = (smp ? it - 256 : it) >> 3, g = it & 7;
            const float* h0 = smp ? KIN(3) + ((size_t)b * 32 + 4 * g) * 8192 : nullptr;
            const float* cc = smp ? KIN(2) + (size_t)b * 3 * CONVD : nullptr;
            float* so = out + (smp ? O_SSMS : O_SSMP) + ((size_t)b * 32 + 4 * g) * 8192;
            ssd_item(lds, XBC, ZY, DT, smp ? MP + b * SSEQ : b * SEQ, smp ? SSEQ : SEQ, g, h0, cc, so, KIN(13), KIN(14), KIN(16), KIN(17));
        }
        for (int i = bid * NTHREADS + TID; i < 40 * 3 * 1024; i += G * NTHREADS) {
            const int c4 = i & 1023, r = (i >> 10) % 3, s = i / 3072;
            const int row = s < 32 ? s * SEQ + SEQ - 3 + r : MP + (s - 32) * SSEQ + SSEQ - 3 + r;
            const u32x2 w = *(const u32x2*)(XBC + (size_t)row * CONVD + 4 * c4);
            float* dst = s < 32 ? out + O_CONVP + ((size_t)s * 3 + r) * CONVD + 4 * c4 : out + O_CONVS + ((size_t)(s - 32) * 3 + r) * CONVD + 4 * c4;
            *(f32x4*)dst = (f32x4){bflo(w.x), bfhi(w.x), bflo(w.y), bfhi(w.y)};
        }
    }
    XBAR();
    small_gemm<SM_WIN2>(lds, WSP(WS_XB) + (size_t)MP * DM, WSP(WS_WIN + (size_t)NWIN1 * DM * 2), 3072, DM, WSP(WS_R2), nullptr, nullptr, nullptr);
    { pg8::Gemm g{WSP(WS_XB), WSP(WS_WIN + (size_t)NWIN1 * DM * 2), MP, 3072, DM}; pg8::StaticOrder S; S.init(MP, 3072, gridDim.x, blockIdx.x); pg8::EpiWin2 E{WSP(WS_R2), (size_t)MT * 1024};
      pg8::gemm_phase<pg8::EpiWin2, pg8::StaticOrder, true, true>(lds, g, S, E); }
    XBAR();
    {
        const int lane = LANE, gw = GW, ngw = NGW;
        const bf16_t* U = WSP(WS_R2); bf16_t* PL = WSP(WS_R2 + 3 * R2S); float* out = KOUT; const float* cpool = KIN(4);
        for (int t = gw; t < 2048 + 16; t += ngw) {
            if (t < 2048) { const int b = t >> 6, c = (t >> 1) & 31, hs = t & 1; pool_task(U, PL, b * SEQ, SEQ, 64 * c, hs, 0, nullptr, lane); }
            else { const int b = (t - 2048) >> 1, hs = t & 1; pool_task(U, PL, MP + b * SSEQ, SSEQ, 0, hs, 4096, cpool + (size_t)b * 15 * DM, lane); }
        }
        for (int i = blockIdx.x * NTHREADS + TID; i < 40 * 15 * 256; i += gridDim.x * NTHREADS) {
            const int c4 = i & 255, r = (i >> 8) % 15, s = i / (15 * 256);
            const int row = s < 32 ? s * SEQ + SEQ - 15 + r : MP + (s - 32) * SSEQ + SSEQ - 15 + r;
            const u32x2 w = *(const u32x2*)(U + (size_t)row * DM + 4 * c4);
            float* dst = s < 32 ? out + O_POOLP + ((size_t)s * 15 + r) * DM + 4 * c4 : out + O_POOLS + ((size_t)(s - 32) * 15 + r) * DM + 4 * c4;
            *(f32x4*)dst = (f32x4){bflo(w.x), bfhi(w.x), bflo(w.y), bfhi(w.y)};
        }
    }
    small_gemm16<SM_GATE0>(lds, WSP(WS_R1) + (size_t)MP * DINNER, WSP(WS_WPS), DINNER, WSP(WS_R2 + R2S), nullptr);
    { pg8::Gemm g{WSP(WS_R1), WSP(WS_WPS), MP, DM, DINNER}; pg8::StaticOrder S; S.init(MP, DM, gridDim.x, blockIdx.x); pg8::EpiGate<0> E{WSP(WS_R2 + R2S), nullptr};
      pg8::gemm_phase<pg8::EpiGate<0>, pg8::StaticOrder, true, true>(lds, g, S, E); }
    XBAR();
    small_gemm16<SM_GATE1>(lds, WSP(WS_R2 + 3 * R2S) + (size_t)MP * DM, WSP(WS_WCOMB), DM, WSP(WS_R2 + 2 * R2S), WSP(WS_R2 + R2S));
    { pg8::Gemm g{WSP(WS_R2 + 3 * R2S), WSP(WS_WCOMB), MP, DM, DM}; pg8::StaticOrder S; S.init(MP, DM, gridDim.x, blockIdx.x); pg8::EpiGate<1> E{WSP(WS_R2 + 2 * R2S), WSP(WS_R2 + R2S)};
      pg8::gemm_phase<pg8::EpiGate<1>, pg8::StaticOrder, true, true>(lds, g, S, E); }
    XBAR();
    small_gemm16<SM_BF16>(lds, WSP(WS_R2 + 2 * R2S) + (size_t)MP * DM, WSP(WS_WOUT), DM, WSP(WS_R1), nullptr);
    { pg8::Gemm g{WSP(WS_R2 + 2 * R2S), WSP(WS_WOUT), MP, DM, DM}; pg8::StaticOrder S; S.init(MP, DM, gridDim.x, blockIdx.x); pg8::EpiBf16 E{WSP(WS_R1), DM};
      pg8::gemm_phase<pg8::EpiBf16, pg8::StaticOrder, true, true>(lds, g, S, E); }
    XBAR();
    { const int lane = LANE, gw = GW, ngw = NGW; const float* gp = KIN(11); float* out = KOUT; const bf16_t* F = WSP(WS_R1); bf16_t* XB = WSP(WS_XB);
      for (int m = 4 * gw; m < MV; m += 4 * ngw) post_rows2<4, false>(XB + (size_t)m * DM, (float*)(KWS + WS_RN) + m, F + (size_t)m * DM, gp, 1.0f, nullptr, lane); }
    XBAR();
    small_gemm<SM_SWIGLU>(lds, WSP(WS_XB) + (size_t)MP * DM, WSP(WS_WGU2), 2 * DFF, DM, WSP(WS_R2), nullptr, nullptr, nullptr);
    { pg8::Gemm g{WSP(WS_XB), WSP(WS_WGU2), MP, 2 * DFF, DM}; pg8::StaticOrder S; S.init(MP, 2 * DFF, gridDim.x, blockIdx.x); pg8::EpiSwiglu E{WSP(WS_R2), DFF};
      pg8::gemm_phase<pg8::EpiSwiglu, pg8::StaticOrder, true, true>(lds, g, S, E); }
    XBAR();
    small_gemm16<SM_BF16>(lds, WSP(WS_R2) + (size_t)MP * DFF, WSP(WS_WD2), DFF, WSP(WS_R1), nullptr);
    { pg8::Gemm g{WSP(WS_R2), WSP(WS_WD2), MP, DM, DFF, 1}; pg8::StaticOrder S; S.init(MP, DM, gridDim.x, blockIdx.x); pg8::EpiBf16 E{WSP(WS_R1), DM};
      pg8::gemm_phase<pg8::EpiBf16, pg8::StaticOrder, true, true>(lds, g, S, E); }
    XBAR();
    { const int lane = LANE, gw = GW, ngw = NGW; const float* gp = KIN(25); float* out = KOUT; const bf16_t* F = WSP(WS_R1);
      for (int m = 4 * gw; m < MV; m += 4 * ngw) post_rows2<4, true>(WSP(WS_XB) + (size_t)m * DM, (float*)(KWS + WS_RN) + m, F + (size_t)m * DM, gp, 0.5f, out + (size_t)m * DM, lane); }
}

extern "C" void kernel_launch(void* const* d_in, const int* in_sizes, int n_in, void* d_out, int out_size, void* d_ws, size_t ws_size, hipStream_t stream) {
    static int grid = 0;
    if (grid == 0) {
        if (n_in != 29 || ws_size < WS_END) { fprintf(stderr, "kernel_launch: unexpected n_in %d / ws_size %zu (need %zu)\n", n_in, ws_size, (size_t)WS_END); grid = -1; return; }
        int dev = 0, cus = 0, per_cu = 0;
        hipGetDevice(&dev); hipDeviceGetAttribute(&cus, hipDeviceAttributeMultiprocessorCount, dev);
        if (hipFuncSetAttribute((const void*)hybrid_fwd, hipFuncAttributeMaxDynamicSharedMemorySize, LDS_BYTES) != hipSuccess) { fprintf(stderr, "kernel_launch: hipFuncSetAttribute failed\n"); grid = -1; return; }
        if (hipOccupancyMaxActiveBlocksPerMultiprocessor(&per_cu, (const void*)hybrid_fwd, NTHREADS, LDS_BYTES) != hipSuccess || per_cu < 1) { fprintf(stderr, "kernel_launch: occupancy query says %d\n", per_cu); per_cu = 1; }
        (void)hipGetLastError();
        grid = cus * (per_cu > 1 ? 1 : per_cu);
        fprintf(stderr, "kernel_launch: grid %d (cus %d, per_cu %d), ws %zu\n", grid, cus, per_cu, ws_size);
    }
    if (grid < 0) return;
    Params p{};
    for (int i = 0; i < 29; ++i) p.in[i] = (const float*)d_in[i];
    p.out = (float*)d_out; p.ws = (unsigned char*)d_ws;
    void* args[] = {&p};
    hipError_t e = hipLaunchCooperativeKernel((const void*)hybrid_fwd, dim3(grid), dim3(NTHREADS), args, LDS_BYTES, stream);
    if (e != hipSuccess) fprintf(stderr, "kernel_launch: cooperative launch failed: %s (grid %d)\n", hipGetErrorString(e), grid);
}
```

```cpp
#include <hip/hip_runtime.h>
#include <hip/hip_cooperative_groups.h>
#include <cstdio>
#include <cstdint>
namespace cg = cooperative_groups;
namespace pg8 {
#define PG8_LAS __attribute__((address_space(3)))
typedef unsigned short bf16_t;
typedef short bf16x8 __attribute__((ext_vector_type(8)));
typedef float f32x4 __attribute__((ext_vector_type(4)));
typedef unsigned u32x4 __attribute__((ext_vector_type(4)));
constexpr int BM = 256, BK = 64, HALF = 128, HTB = HALF * BK * 2  , STAGE_BYTES = 8 * HTB, NXCD = 8, WGM = 8;

__host__ __device__ __forceinline__ int lds_byte(int r, int c) { const int st = (r >> 4) * 2 + (c >> 5), rr = r & 15, cc = c & 31, ob = rr * 64 + cc * 2; return st * 1024 + (ob ^ (((ob >> 9) & 1) << 5)); }
__host__ __device__ __forceinline__ void stage_rc(int b, int& R, int& C) { const int st = b / 1024, sb = b % 1024, swz = sb ^ (((sb >> 9) & 1) << 5); R = (st >> 1) * 16 + swz / 64; C = (st & 1) * 32 + (swz % 64) / 2; }
__host__ __device__ __forceinline__ int perm32(int rho) { const int n = rho >> 4, i = rho & 15; return 8 * (i >> 2) + 4 * n + (i & 3); }

struct Unit { int pm, pn; };
struct Gemm { const bf16_t* A; const bf16_t* Bt; int M, N, K; int ablk; };

struct StaticOrder {
    int nM, nN, nwg, G, c;
    __host__ __device__ void init(int M, int N, int G_, int c_) { nM = M / BM; nN = N / BM; nwg = nM * nN; G = G_; c = c_; }
    __host__ __device__ bool next(int i, Unit& u) const {
        const long L = (long)i * G + c; if (L >= nwg) return false;
        int wgid = (int)L; { const int q = nwg / NXCD, r = nwg % NXCD, xcd = wgid % NXCD, off = wgid / NXCD; wgid = (xcd < r ? xcd * (q + 1) : r * (q + 1) + (xcd - r) * q) + off; }
        const int nig = WGM * nN, gid = wgid / nig, fm = gid * WGM, gsz = (nM - fm) < WGM ? (nM - fm) : WGM;
        u.pm = fm + ((wgid % nig) % gsz); u.pn = (wgid % nig) / gsz; return true;
    }
    __device__ __forceinline__ void a_ready(const Unit&) const {}
    __device__ __forceinline__ void done(const Unit&) const {}
};

typedef __bf16 bf16x2_t __attribute__((ext_vector_type(2)));
typedef float f32x2 __attribute__((ext_vector_type(2)));
__device__ __forceinline__ unsigned pk2(float lo, float hi) { f32x2 v = {lo, hi}; bf16x2_t r = __builtin_convertvector(v, bf16x2_t); return __builtin_bit_cast(unsigned, r); }
__device__ __forceinline__ float bflo(unsigned u) { return __uint_as_float(u << 16); }
__device__ __forceinline__ float bfhi(unsigned u) { return __uint_as_float(u & 0xffff0000u); }
__device__ __forceinline__ float fast_sigmoid(float x) { return __builtin_amdgcn_rcpf(1.0f + __builtin_amdgcn_exp2f(-1.44269504089f * x)); }
__device__ __forceinline__ float fast_silu(float x) { return x * fast_sigmoid(x); }
__device__ __forceinline__ f32x4 sigmoid4(f32x4 x) {
    const f32x4 t = x * (-1.44269504089f); f32x4 ex;
    ex[0] = __builtin_amdgcn_exp2f(t[0]); ex[1] = __builtin_amdgcn_exp2f(t[1]); ex[2] = __builtin_amdgcn_exp2f(t[2]); ex[3] = __builtin_amdgcn_exp2f(t[3]);
    const f32x4 d = ex + 1.0f; f32x4 r;
    r[0] = __builtin_amdgcn_rcpf(d[0]); r[1] = __builtin_amdgcn_rcpf(d[1]); r[2] = __builtin_amdgcn_rcpf(d[2]); r[3] = __builtin_amdgcn_rcpf(d[3]);
    return r;
}
__device__ __forceinline__ f32x4 silu4(f32x4 x) {
    const f32x4 t = x * (-1.44269504089f); f32x4 ex;
    ex[0] = __builtin_amdgcn_exp2f(t[0]); ex[1] = __builtin_amdgcn_exp2f(t[1]); ex[2] = __builtin_amdgcn_exp2f(t[2]); ex[3] = __builtin_amdgcn_exp2f(t[3]);
    const f32x4 d = ex + 1.0f; f32x4 r;
    r[0] = __builtin_amdgcn_rcpf(d[0]); r[1] = __builtin_amdgcn_rcpf(d[1]); r[2] = __builtin_amdgcn_rcpf(d[2]); r[3] = __builtin_amdgcn_rcpf(d[3]);
    return x * r;
}

struct EpiBf16 {
    static constexpr bool PERM = true, AFTER_DRAIN = false;
    bf16_t* O; int ldc;
    __device__ __forceinline__ void operator()(const f32x4 (&acc)[2][2][4][2], const Unit& u, int wr, int wc, int fr, int fq) const {
        const int row0 = u.pm * BM + wr * 64 + fr; const int col0 = u.pn * BM + wc * 32 + 8 * fq;
#pragma unroll
        for (int ai = 0; ai < 2; ++ai)
#pragma unroll
            for (int m = 0; m < 4; ++m) { bf16_t* rowp = O + (size_t)(row0 + ai * HALF + m * 16) * ldc + col0;
#pragma unroll
                for (int bj = 0; bj < 2; ++bj) { const f32x4 v0 = acc[ai][bj][m][0], v1 = acc[ai][bj][m][1];
                    u32x4 w; w.x = pk2(v0[0], v0[1]); w.y = pk2(v0[2], v0[3]); w.z = pk2(v1[0], v1[1]); w.w = pk2(v1[2], v1[3]);
                    *(u32x4*)(rowp + bj * HALF) = w; } }
    }
};
struct EpiSwiglu {
    static constexpr bool PERM = false, AFTER_DRAIN = false;
    bf16_t* H; int ldh;
    __device__ __forceinline__ void operator()(const f32x4 (&acc)[2][2][4][2], const Unit& u, int wr, int wc, int fr, int fq) const {
        const int row0 = u.pm * BM + wr * 64 + fr; const int hcol = u.pn * 128 + wc * 32 + 8 * fq;
#pragma unroll
        for (int ai = 0; ai < 2; ++ai)
#pragma unroll
            for (int m = 0; m < 4; ++m) {
                bf16_t* rowp = H + (((size_t)u.pm * (ldh >> 6) + (hcol >> 6)) * BM + (wr * 64 + fr + ai * HALF + m * 16)) * 64 + (hcol & 63);
                const f32x4 g0 = acc[ai][0][m][0], u0 = acc[ai][0][m][1], g1 = acc[ai][1][m][0], u1 = acc[ai][1][m][1];
                const f32x4 h0 = silu4(g0) * u0, h1 = silu4(g1) * u1;
                u32x4 w; w.x = pk2(h0[0], h0[1]); w.y = pk2(h0[2], h0[3]); w.z = pk2(h1[0], h1[1]); w.w = pk2(h1[2], h1[3]);
                *(u32x4*)rowp = w; }
    }
};
struct EpiWin1 {
    static constexpr bool PERM = true, AFTER_DRAIN = false;
    bf16_t* Z; bf16_t* XBC; float* DT; const float* dt_bias;
    __device__ __forceinline__ void operator()(const f32x4 (&acc)[2][2][4][2], const Unit& u, int wr, int wc, int fr, int fq) const {
        const int row0 = u.pm * BM + wr * 64 + fr;
        if (u.pn < 24) {
            bf16_t* base; int ldc, colt;
            if (u.pn < 8) { base = Z; ldc = 2048; colt = u.pn * BM; } else { base = XBC; ldc = 4096; colt = (u.pn - 8) * BM; }
            const int col0 = colt + wc * 32 + 8 * fq;
#pragma unroll
            for (int ai = 0; ai < 2; ++ai)
#pragma unroll
                for (int m = 0; m < 4; ++m) { bf16_t* rowp = base + (size_t)(row0 + ai * HALF + m * 16) * ldc + col0;
#pragma unroll
                    for (int bj = 0; bj < 2; ++bj) { const f32x4 v0 = acc[ai][bj][m][0], v1 = acc[ai][bj][m][1];
                        u32x4 w; w.x = pk2(v0[0], v0[1]); w.y = pk2(v0[2], v0[3]); w.z = pk2(v1[0], v1[1]); w.w = pk2(v1[2], v1[3]);
                        *(u32x4*)(rowp + bj * HALF) = w; } }
        } else if (wc == 0) {
            const int col0 = 8 * fq;
            const f32x4 b0 = *(const f32x4*)(dt_bias + col0), b1 = *(const f32x4*)(dt_bias + col0 + 4);
#pragma unroll
            for (int ai = 0; ai < 2; ++ai)
#pragma unroll
                for (int m = 0; m < 4; ++m) { float* rowp = DT + (size_t)(row0 + ai * HALF + m * 16) * 32 + col0;
                    f32x4 v0 = acc[ai][0][m][0] + b0, v1 = acc[ai][0][m][1] + b1;
#pragma unroll
                    for (int j = 0; j < 4; ++j) { v0[j] = fmaxf(v0[j], 0.f) + log1pf(expf(-fabsf(v0[j]))); v1[j] = fmaxf(v1[j], 0.f) + log1pf(expf(-fabsf(v1[j]))); }
                    *(f32x4*)rowp = v0; *(f32x4*)(rowp + 4) = v1; }
        }
    }
};
struct EpiWin2 {
    static constexpr bool PERM = true, AFTER_DRAIN = false;
    bf16_t* U; size_t stride;
    __device__ __forceinline__ void operator()(const f32x4 (&acc)[2][2][4][2], const Unit& u, int wr, int wc, int fr, int fq) const {
        const int row0 = u.pm * BM + wr * 64 + fr; const int t = u.pn >> 2; const bool sg = t != 0;
        bf16_t* base = U + (size_t)t * stride; const int col0 = (u.pn & 3) * BM + wc * 32 + 8 * fq;
#pragma unroll
        for (int ai = 0; ai < 2; ++ai)
#pragma unroll
            for (int m = 0; m < 4; ++m) { bf16_t* rowp = base + (size_t)(row0 + ai * HALF + m * 16) * 1024 + col0;
#pragma unroll
                for (int bj = 0; bj < 2; ++bj) { f32x4 v0 = acc[ai][bj][m][0], v1 = acc[ai][bj][m][1];
                    if (sg) { v0 = sigmoid4(v0); v1 = sigmoid4(v1); }
                    u32x4 w; w.x = pk2(v0[0], v0[1]); w.y = pk2(v0[2], v0[3]); w.z = pk2(v1[0], v1[1]); w.w = pk2(v1[2], v1[3]);
                    *(u32x4*)(rowp + bj * HALF) = w; } }
    }
};
template <int MODE> struct EpiGate {
    static constexpr bool PERM = true, AFTER_DRAIN = false;
    bf16_t* G; const bf16_t* T;
    __device__ __forceinline__ void operator()(const f32x4 (&acc)[2][2][4][2], const Unit& u, int wr, int wc, int fr, int fq) const {
        const int row0 = u.pm * BM + wr * 64 + fr; const int col0 = u.pn * BM + wc * 32 + 8 * fq;
#pragma unroll
        for (int ai = 0; ai < 2; ++ai)
#pragma unroll
            for (int m = 0; m < 4; ++m) { const size_t off = (size_t)(row0 + ai * HALF + m * 16) * 1024 + col0;
#pragma unroll
                for (int bj = 0; bj < 2; ++bj) { const f32x4 v0 = acc[ai][bj][m][0], v1 = acc[ai][bj][m][1];
                    const u32x4 g = *(const u32x4*)(G + off + bj * HALF);
                    float r[8] = {bflo(g.x) * v0[0], bfhi(g.x) * v0[1], bflo(g.y) * v0[2], bfhi(g.y) * v0[3], bflo(g.z) * v1[0], bfhi(g.z) * v1[1], bflo(g.w) * v1[2], bfhi(g.w) * v1[3]};
                    if (MODE == 1) { const u32x4 t = *(const u32x4*)(T + off + bj * HALF);
                        r[0] += bflo(t.x); r[1] += bfhi(t.x); r[2] += bflo(t.y); r[3] += bfhi(t.y); r[4] += bflo(t.z); r[5] += bfhi(t.z); r[6] += bflo(t.w); r[7] += bfhi(t.w); }
                    u32x4 w; w.x = pk2(r[0], r[1]); w.y = pk2(r[2], r[3]); w.z = pk2(r[4], r[5]); w.w = pk2(r[6], r[7]);
                    *(u32x4*)(G + off + bj * HALF) = w; } }
    }
};

template <class Epi, class Sched, bool ALIGN_EPI = false, bool SP2 = false>
__device__ __forceinline__ void gemm_phase(PG8_LAS unsigned char* lds, const Gemm g, const Sched& S, const Epi& E) {
    int tid_ = threadIdx.x; asm volatile("" : "+v"(tid_));
    const int tid = tid_, wid = __builtin_amdgcn_readfirstlane(tid >> 6), lane = tid & 63, wr = wid >> 2, wc = wid & 3, fr = lane & 15, fq = lane >> 4;
    const int K = g.K, nt = K / BK;
    unsigned voffA[2], voffB[2];
#pragma unroll
    for (int i = 0; i < 2; ++i) { int R, C; stage_rc(tid * 16 + i * 8192, R, C); const int Rb = Epi::PERM ? ((R & ~31) + perm32(R & 31)) : R;
        voffA[i] = g.ablk ? (unsigned)(R * BK + C) * 2u : (unsigned)(R * K + C) * 2u; voffB[i] = (unsigned)(Rb * K + C) * 2u; }
    const size_t kstep = (size_t)(BK * 2);
    const size_t hstep = (size_t)HALF * K * 2;
    const size_t tstep = 2 * hstep;
    const size_t kstepA = g.ablk ? (size_t)(BM * BK * 2) : kstep, hstepA = g.ablk ? (size_t)(HALF * BK * 2) : hstep, tstepA = g.ablk ? (size_t)(K / BK) * (BM * BK * 2) : tstep;
    const unsigned ldsw = (unsigned)wid * 1024u;
    const int aoff = lds_byte(wr * 64 + fr, fq * 8), boff = lds_byte(wc * 32 + fr, fq * 8);
#define PG8_SA(b, h) (((b) * 2 + (h)) * HTB)
#define PG8_SB(b, h) ((4 + (b) * 2 + (h)) * HTB)
#define PG8_STAGE(bufoff, gbase, voff) do { _Pragma("unroll") for (int _i = 0; _i < 2; ++_i) \
        __builtin_amdgcn_global_load_lds((const unsigned*)((const char*)(gbase) + (voff)[_i]), (PG8_LAS unsigned*)(lds + (bufoff) + ldsw + _i * 8192), 16, 0, 0); } while (0)
#define PG8_LDA(dst, b, h) do { _Pragma("unroll") for (int m = 0; m < 4; ++m) _Pragma("unroll") for (int k = 0; k < 2; ++k) dst[m][k] = *(const PG8_LAS bf16x8*)(lds + PG8_SA(b, h) + aoff + m * 2048 + k * 1024); } while (0)
#define PG8_LDB(dst, b, h) do { _Pragma("unroll") for (int n = 0; n < 2; ++n) _Pragma("unroll") for (int k = 0; k < 2; ++k) dst[n][k] = *(const PG8_LAS bf16x8*)(lds + PG8_SB(b, h) + boff + n * 2048 + k * 1024); } while (0)
#define PG8_MMA(ai, bj, At, Bt) do { __builtin_amdgcn_s_setprio(1); _Pragma("unroll") for (int m = 0; m < 4; ++m) _Pragma("unroll") for (int n = 0; n < 2; ++n) _Pragma("unroll") for (int k = 0; k < 2; ++k) \
        acc[ai][bj][m][n] = __builtin_amdgcn_mfma_f32_16x16x32_bf16(Bt[n][k], At[m][k], acc[ai][bj][m][n], 0, 0, 0); __builtin_amdgcn_s_setprio(0); } while (0)
#define PG8_WAIT_V(n) asm volatile("s_waitcnt vmcnt(" #n ")" ::: "memory")
#define PG8_WAIT_L(n) asm volatile("s_waitcnt lgkmcnt(" #n ")" ::: "memory")
#define PG8_BAR __builtin_amdgcn_s_barrier()
#define PG8_SCHED __builtin_amdgcn_sched_barrier(0)
    Unit cur, nxt; int ui = 0;
    if (!S.next(0, cur)) return;
    f32x4 acc[2][2][4][2];
#pragma unroll
    for (int a = 0; a < 2; ++a)
#pragma unroll
        for (int b = 0; b < 2; ++b)
#pragma unroll
            for (int m = 0; m < 4; ++m)
#pragma unroll
                for (int n = 0; n < 2; ++n) acc[a][b][m][n] = (f32x4){0.f, 0.f, 0.f, 0.f};
    bf16x8 At[4][2], B0[2][2], B1[2][2];
    const char* cA = (const char*)g.A + (size_t)cur.pm * tstepA; const char* cB = (const char*)g.Bt + (size_t)cur.pn * tstep;
    S.a_ready(cur);
    if constexpr (SP2) {
        PG8_STAGE(PG8_SB(0, 0), cB, voffB); PG8_STAGE(PG8_SB(0, 1), cB + hstep, voffB); PG8_STAGE(PG8_SA(0, 0), cA, voffA); PG8_STAGE(PG8_SA(0, 1), cA + hstepA, voffA);
        if (wr == 1) PG8_BAR;
        PG8_WAIT_V(2); PG8_BAR;
        PG8_STAGE(PG8_SB(1, 0), cB + kstep, voffB); PG8_STAGE(PG8_SA(1, 0), cA + kstepA, voffA); PG8_STAGE(PG8_SB(1, 1), cB + hstep + kstep, voffB);
        PG8_WAIT_V(6); PG8_BAR;
    } else {
        PG8_STAGE(PG8_SB(0, 0), cB, voffB); PG8_STAGE(PG8_SA(0, 0), cA, voffA); PG8_STAGE(PG8_SB(0, 1), cB + hstep, voffB); PG8_STAGE(PG8_SA(0, 1), cA + hstepA, voffA);
        if (wr == 1) PG8_BAR;
        PG8_WAIT_V(4); PG8_BAR;
        PG8_STAGE(PG8_SB(1, 0), cB + kstep, voffB); PG8_STAGE(PG8_SA(1, 0), cA + kstepA, voffA); PG8_STAGE(PG8_SB(1, 1), cB + hstep + kstep, voffB);
        PG8_WAIT_V(6); PG8_BAR;
    }
    for (;;) {
        const bool has_next = S.next(ui + 1, nxt);
        const char* nA = has_next ? (const char*)g.A + (size_t)nxt.pm * tstepA : cA; const char* nB = has_next ? (const char*)g.Bt + (size_t)nxt.pn * tstep : cB;
        for (int t = 0; t < nt; t += 2) {
            const bool last = (t == nt - 2);
            const char* a1 = cA + (size_t)(t + 1) * kstepA;
            const char* a2 = last ? nA : cA + (size_t)(t + 2) * kstepA; const char* b2 = last ? nB : cB + (size_t)(t + 2) * kstep;
            const char* a3 = a2 + kstepA; const char* b3 = b2 + kstep;
            if (last && has_next) S.a_ready(nxt);
            if constexpr (SP2) {
            PG8_LDB(B0, 0, 0); PG8_LDB(B1, 0, 1); PG8_SCHED; PG8_LDA(At, 0, 0); PG8_STAGE(PG8_SA(1, 1), a1 + hstepA, voffA);
            PG8_WAIT_V(8); PG8_WAIT_L(0); PG8_BAR; PG8_MMA(0, 0, At, B0); PG8_MMA(0, 1, At, B1); PG8_BAR; PG8_SCHED;
            PG8_LDA(At, 0, 1); PG8_STAGE(PG8_SB(0, 0), b2, voffB); PG8_STAGE(PG8_SB(0, 1), b2 + hstep, voffB); PG8_STAGE(PG8_SA(0, 0), a2, voffA);
            PG8_WAIT_V(8); PG8_WAIT_L(0); PG8_BAR; PG8_MMA(1, 0, At, B0); PG8_MMA(1, 1, At, B1); PG8_BAR; PG8_SCHED;
            PG8_LDB(B0, 1, 0); PG8_LDB(B1, 1, 1); PG8_SCHED; PG8_LDA(At, 1, 0); PG8_STAGE(PG8_SA(0, 1), a2 + hstepA, voffA);
            PG8_WAIT_V(8); PG8_WAIT_L(0); PG8_BAR; PG8_MMA(0, 0, At, B0); PG8_MMA(0, 1, At, B1); PG8_BAR; PG8_SCHED;
            PG8_LDA(At, 1, 1); PG8_STAGE(PG8_SB(1, 0), b3, voffB); PG8_STAGE(PG8_SB(1, 1), b3 + hstep, voffB); PG8_STAGE(PG8_SA(1, 0), a3, voffA);
            PG8_WAIT_V(8); PG8_WAIT_L(0); PG8_BAR; PG8_MMA(1, 0, At, B0); PG8_MMA(1, 1, At, B1); PG8_BAR; PG8_SCHED;
            } else {
            PG8_LDB(B0, 0, 0); PG8_SCHED; PG8_LDA(At, 0, 0); PG8_STAGE(PG8_SA(1, 1), a1 + hstepA, voffA);
            PG8_WAIT_L(8); PG8_BAR; PG8_WAIT_L(0); PG8_MMA(0, 0, At, B0); PG8_BAR; PG8_SCHED;
            PG8_LDB(B1, 0, 1); PG8_STAGE(PG8_SB(0, 0), b2, voffB);
            PG8_BAR; PG8_WAIT_L(0); PG8_MMA(0, 1, At, B1); PG8_BAR;
            PG8_LDA(At, 0, 1); PG8_STAGE(PG8_SA(0, 0), a2, voffA);
            PG8_BAR; PG8_WAIT_L(0); PG8_MMA(1, 0, At, B0); PG8_BAR; PG8_SCHED;
            PG8_STAGE(PG8_SB(0, 1), b2 + hstep, voffB);
            PG8_WAIT_V(6); PG8_BAR; PG8_MMA(1, 1, At, B1); PG8_BAR;
            PG8_LDB(B0, 1, 0); PG8_SCHED; PG8_LDA(At, 1, 0); PG8_STAGE(PG8_SA(0, 1), a2 + hstepA, voffA);
            PG8_WAIT_L(8); PG8_BAR; PG8_WAIT_L(0); PG8_MMA(0, 0, At, B0); PG8_BAR; PG8_SCHED;
            PG8_LDB(B1, 1, 1); PG8_STAGE(PG8_SB(1, 0), b3, voffB);
            PG8_BAR; PG8_WAIT_L(0); PG8_MMA(0, 1, At, B1); PG8_BAR;
            PG8_LDA(At, 1, 1); PG8_STAGE(PG8_SA(1, 0), a3, voffA);
            PG8_BAR; PG8_WAIT_L(0); PG8_MMA(1, 0, At, B0); PG8_BAR; PG8_SCHED;
            PG8_STAGE(PG8_SB(1, 1), b3 + hstep, voffB);
            PG8_WAIT_V(6); PG8_BAR; PG8_MMA(1, 1, At, B1); PG8_BAR;
            }
        }
        if constexpr (ALIGN_EPI) { if (wr == 0) PG8_BAR; }
        if constexpr (!Epi::AFTER_DRAIN) { E(acc, cur, wr, wc, fr, fq); S.done(cur); }
        if (!has_next) break;
#pragma unroll
        for (int a = 0; a < 2; ++a)
#pragma unroll
            for (int b = 0; b < 2; ++b)
#pragma unroll
                for (int m = 0; m < 4; ++m)
#pragma unroll
                    for (int n = 0; n < 2; ++n) acc[a][b][m][n] = (f32x4){0.f, 0.f, 0.f, 0.f};
        cur = nxt; cA = nA; cB = nB; ++ui;
        if constexpr (ALIGN_EPI) { if (wr == 1) PG8_BAR; }
    }
    PG8_WAIT_V(0);
    if constexpr (!ALIGN_EPI) { if (wr == 0) PG8_BAR; }
    PG8_BAR;
    if constexpr (Epi::AFTER_DRAIN) { E.fused(acc, cur, wr, wc, fr, fq, lds, wid, lane); S.done(cur); }
#undef PG8_SA
#undef PG8_SB
#undef PG8_STAGE
#undef PG8_LDA
#undef PG8_LDB
#undef PG8_MMA
#undef PG8_WAIT_V
#undef PG8_WAIT_L
#undef PG8_BAR
#undef PG8_SCHED
}
}

#define LAS __attribute__((address_space(3)))
typedef unsigned short bf16_t;
typedef short bf16x8 __attribute__((ext_vector_type(8)));
typedef float f32x4 __attribute__((ext_vector_type(4)));
typedef float f32x16 __attribute__((ext_vector_type(16)));
typedef unsigned u32x4 __attribute__((ext_vector_type(4)));
typedef unsigned u32x2 __attribute__((ext_vector_type(2)));
using pg8::pk2; using pg8::bflo; using pg8::bfhi; using pg8::fast_sigmoid; using pg8::fast_silu; using pg8::silu4;

constexpr int DM = 1024, SEQ = 2048, NB = 32, DFF = 2816, DINNER = 2048, CONVD = 4096;
constexpr int SB = 8, SSEQ = 16;
constexpr int MP = NB * SEQ;
constexpr int MS = SB * SSEQ;
constexpr int MV = MP + MS;
constexpr int MT = MP + 256;
constexpr int NWIN1 = 6400, NWIN = 9472;
constexpr float EPS = 1e-6f;
constexpr int NTHREADS = 512, NWAVES = 8;
constexpr int LDS_BYTES = 147456;

constexpr size_t O_YP = 0, O_YS = 67108864, O_CONVP = 67239936, O_SSMP = 67633152, O_POOLP = 76021760, O_CONVS = 76513280, O_SSMS = 76611584, O_POOLS = 78708736;

constexpr size_t MiB = 1u << 20;
constexpr size_t WS_WGU1 = 1 * MiB;
constexpr size_t WS_WD1 = WS_WGU1 + (size_t)5632 * 1024 * 2;
constexpr size_t WS_WIN = WS_WD1 + (size_t)1024 * 2816 * 2;
constexpr size_t WS_WPS = WS_WIN + (size_t)NWIN * 1024 * 2;
constexpr size_t WS_WCOMB = WS_WPS + (size_t)1024 * 2048 * 2;
constexpr size_t WS_WOUT = WS_WCOMB + (size_t)1024 * 1024 * 2;
constexpr size_t WS_WGU2 = WS_WOUT + (size_t)1024 * 1024 * 2;
constexpr size_t WS_WD2 = WS_WGU2 + (size_t)5632 * 1024 * 2;
constexpr size_t WS_WEND = WS_WD2 + (size_t)1024 * 2816 * 2;
static_assert(WS_WEND <= 61 * MiB, "weights");
constexpr size_t WS_DT = 61 * MiB;
constexpr size_t WS_RN = 69 * MiB + 512 * 1024;
constexpr size_t WS_XB = 70 * MiB;
constexpr size_t WS_R1 = 199 * MiB;
constexpr size_t WS_R2 = 456 * MiB;
constexpr size_t WS_END = WS_R2 + (size_t)MT * 4096 * 2;
static_assert(WS_DT + (size_t)MT * 32 * 4 <= WS_RN && WS_RN + (size_t)MT * 4 <= WS_XB && WS_XB + (size_t)MT * 1024 * 2 <= WS_R1 && WS_R1 + (size_t)MT * 2048 * 2 <= WS_R2 && WS_END <= 1024 * MiB, "ws map");

__device__ __forceinline__ float wave_sum(float v) {
#pragma unroll
    for (int o = 1; o < 64; o <<= 1) v += __shfl_xor(v, o);
    return v;
}

template <int MODE>
__device__ __forceinline__ void wt_item(const float* W0, const float* W1, int N, int K, const float* kscale, bf16_t* WT, int nblk, LAS float* scr, int item, int lane) {
    const int kb = item / nblk, nb = item % nblk, k0 = 64 * kb, n0 = 32 * nb;
    const int np = n0 + (lane & 31);
    const float* src = W0; int col = np;
    if (MODE == 1) { const int pn = np >> 8, c = np & 255, bj = c >> 7, wc = (c >> 5) & 3, n = (c >> 4) & 1, fq = (c >> 2) & 3, i = c & 3;
        col = 128 * pn + 32 * wc + 8 * fq + 4 * bj + i; src = n ? W1 : W0; }
    if (MODE == 2) { col = np < 6176 ? np : (np < 6400 ? -1 : np - 224); }
    {
        const int n4 = 4 * (lane & 7), npq = n0 + n4;
        const float* srcq = W0; int colq = npq;
        if (MODE == 1) { const int pn = npq >> 8, c = npq & 255, bj = c >> 7, wc = (c >> 5) & 3, n = (c >> 4) & 1, fq = (c >> 2) & 3;
            colq = 128 * pn + 32 * wc + 8 * fq + 4 * bj; srcq = n ? W1 : W0; }
        if (MODE == 2) { colq = npq < 6176 ? npq : (npq < 6400 ? -1 : npq - 224); }
#pragma unroll
        for (int i = 0; i < 8; ++i) { const int kk = 8 * i + (lane >> 3);
            f32x4 v = {0.f, 0.f, 0.f, 0.f};
            if (colq >= 0) { v = *(const f32x4*)(srcq + (size_t)(k0 + kk) * N + colq); if (kscale) v = v * kscale[k0 + kk]; }
            LAS float* d = scr + kk * 33 + n4; d[0] = v[0]; d[1] = v[1]; d[2] = v[2]; d[3] = v[3]; }
    }
    asm volatile("s_waitcnt lgkmcnt(0)" ::: "memory");
    const int c = lane & 7;
#pragma unroll
    for (int j = 0; j < 4; ++j) { const int n = (lane >> 3) + 8 * j; const LAS float* s = scr + (8 * c) * 33 + n;
        u32x4 o; o.x = pk2(s[0 * 33], s[1 * 33]); o.y = pk2(s[2 * 33], s[3 * 33]); o.z = pk2(s[4 * 33], s[5 * 33]); o.w = pk2(s[6 * 33], s[7 * 33]);
        *(u32x4*)(WT + (size_t)(n0 + n) * K + k0 + 8 * c) = o; }
    asm volatile("s_waitcnt lgkmcnt(0)" ::: "memory");
}

__device__ __forceinline__ void wcomb_task(const float* mix, const float* scale, const float* wpp, bf16_t* WC, int task, int lane) {
    const int nb = task & 15, klb = (task >> 4) & 31, g = task >> 9;
    const int n = nb * 64 + lane, kl0 = klb * 8;
    float acc[8];
#pragma unroll
    for (int i = 0; i < 8; ++i) acc[i] = 0.f;
    const float* mrow = mix + ((size_t)g * 256 + kl0) * 256;
    for (int j = 0; j < 256; j += 4) {
        const f32x4 sc4 = *(const f32x4*)(scale + 256 * g + j);
        float w[4];
#pragma unroll
        for (int e = 0; e < 4; ++e) w[e] = sc4[e] * wpp[(size_t)(256 * g + j + e) * 1024 + n];
#pragma unroll
        for (int i = 0; i < 8; ++i) { const f32x4 m4 = *(const f32x4*)(mrow + i * 256 + j);
            acc[i] += (m4[0] * w[0] + m4[1] * w[1]) + (m4[2] * w[2] + m4[3] * w[3]); }
    }
    u32x4 o; o.x = pk2(acc[0], acc[1]); o.y = pk2(acc[2], acc[3]); o.z = pk2(acc[4], acc[5]); o.w = pk2(acc[6], acc[7]);
    *(u32x4*)(WC + (size_t)n * 1024 + 256 * g + kl0) = o;
}

__device__ __forceinline__ void norm_row_to_bf16(const float* xrow, bf16_t* orow, int lane) {
    const f32x4* xr = (const f32x4*)xrow + lane;
    f32x4 v[4]; float s = 0.f;
#pragma unroll
    for (int j = 0; j < 4; ++j) { v[j] = xr[64 * j]; s += (v[j].x * v[j].x + v[j].y * v[j].y) + (v[j].z * v[j].z + v[j].w * v[j].w); }
    const float rstd = rsqrtf(wave_sum(s) * (1.f / DM) + EPS);
    u32x2* o8 = (u32x2*)orow + lane;
#pragma unroll
    for (int j = 0; j < 4; ++j) { u32x2 w; w.x = pk2(v[j].x * rstd, v[j].y * rstd); w.y = pk2(v[j].z * rstd, v[j].w * rstd); o8[64 * j] = w; }
}

__device__ __forceinline__ void post_row(const float* xin, const bf16_t* frow, const float* gpost, float c, float* xout, bf16_t* xb, int lane) {
    const f32x4* xr = (const f32x4*)xin + lane; const u32x2* fr = (const u32x2*)frow + lane; const f32x4* gr = (const f32x4*)gpost + lane;
    f32x4 f[4]; float s = 0.f;
#pragma unroll
    for (int j = 0; j < 4; ++j) { const u32x2 w = fr[64 * j]; f[j] = (f32x4){bflo(w.x), bfhi(w.x), bflo(w.y), bfhi(w.y)}; s += (f[j].x * f[j].x + f[j].y * f[j].y) + (f[j].z * f[j].z + f[j].w * f[j].w); }
    const float rf = c * rsqrtf(wave_sum(s) * (1.f / DM) + EPS);
    f32x4 v[4]; float s2 = 0.f;
#pragma unroll
    for (int j = 0; j < 4; ++j) { v[j] = xr[64 * j] + f[j] * rf * gr[64 * j]; s2 += (v[j].x * v[j].x + v[j].y * v[j].y) + (v[j].z * v[j].z + v[j].w * v[j].w); }
    f32x4* xo = (f32x4*)xout + lane;
#pragma unroll
    for (int j = 0; j < 4; ++j) xo[64 * j] = v[j];
    if (xb) {
        const float rstd = rsqrtf(wave_sum(s2) * (1.f / DM) + EPS);
        u32x2* o8 = (u32x2*)xb + lane;
#pragma unroll
        for (int j = 0; j < 4; ++j) { u32x2 w; w.x = pk2(v[j].x * rstd, v[j].y * rstd); w.y = pk2(v[j].z * rstd, v[j].w * rstd); o8[64 * j] = w; }
    }
}


template <int R>
__device__ __forceinline__ void post_rows(const float* xin, const bf16_t* frow, const float* gpost, float c, float* xout, bf16_t* xb, int lane) {
    f32x4 f[R][4], v[R][4]; float s[R];
#pragma unroll
    for (int r = 0; r < R; ++r) { const u32x2* fr = (const u32x2*)(frow + (size_t)r * DM) + lane; const f32x4* xr = (const f32x4*)(xin + (size_t)r * DM) + lane;
#pragma unroll
        for (int j = 0; j < 4; ++j) { const u32x2 w = fr[64 * j]; f[r][j] = (f32x4){bflo(w.x), bfhi(w.x), bflo(w.y), bfhi(w.y)}; v[r][j] = xr[64 * j]; } }
    f32x4 g[4];
#pragma unroll
    for (int j = 0; j < 4; ++j) g[j] = ((const f32x4*)gpost + lane)[64 * j];
#pragma unroll
    for (int r = 0; r < R; ++r) { s[r] = 0.f;
#pragma unroll
        for (int j = 0; j < 4; ++j) s[r] += (f[r][j].x * f[r][j].x + f[r][j].y * f[r][j].y) + (f[r][j].z * f[r][j].z + f[r][j].w * f[r][j].w); }
#pragma unroll
    for (int o = 1; o < 64; o <<= 1) {
#pragma unroll
        for (int r = 0; r < R; ++r) s[r] += __shfl_xor(s[r], o); }
    float s2[R];
#pragma unroll
    for (int r = 0; r < R; ++r) { const float rf = c * rsqrtf(s[r] * (1.f / DM) + EPS); s2[r] = 0.f; f32x4* xo = (f32x4*)(xout + (size_t)r * DM) + lane;
#pragma unroll
        for (int j = 0; j < 4; ++j) { v[r][j] = v[r][j] + f[r][j] * rf * g[j]; s2[r] += (v[r][j].x * v[r][j].x + v[r][j].y * v[r][j].y) + (v[r][j].z * v[r][j].z + v[r][j].w * v[r][j].w); xo[64 * j] = v[r][j]; } }
    if (xb) {
#pragma unroll
        for (int o = 1; o < 64; o <<= 1) {
#pragma unroll
            for (int r = 0; r < R; ++r) s2[r] += __shfl_xor(s2[r], o); }
#pragma unroll
        for (int r = 0; r < R; ++r) { const float rstd = rsqrtf(s2[r] * (1.f / DM) + EPS); u32x2* o8 = (u32x2*)(xb + (size_t)r * DM) + lane;
#pragma unroll
            for (int j = 0; j < 4; ++j) { u32x2 w; w.x = pk2(v[r][j].x * rstd, v[r][j].y * rstd); w.y = pk2(v[r][j].z * rstd, v[r][j].w * rstd); o8[64 * j] = w; } }
    }
}
template <int R>
__device__ __forceinline__ void norm_rows_to_bf16(const float* xrow, bf16_t* orow, float* rn, int lane) {
    f32x4 v[R][4]; float s[R];
#pragma unroll
    for (int r = 0; r < R; ++r) { const f32x4* xr = (const f32x4*)(xrow + (size_t)r * DM) + lane; s[r] = 0.f;
#pragma unroll
        for (int j = 0; j < 4; ++j) v[r][j] = xr[64 * j]; }
#pragma unroll
    for (int r = 0; r < R; ++r)
#pragma unroll
        for (int j = 0; j < 4; ++j) s[r] += (v[r][j].x * v[r][j].x + v[r][j].y * v[r][j].y) + (v[r][j].z * v[r][j].z + v[r][j].w * v[r][j].w);
#pragma unroll
    for (int o = 1; o < 64; o <<= 1) {
#pragma unroll
        for (int r = 0; r < R; ++r) s[r] += __shfl_xor(s[r], o); }
#pragma unroll
    for (int r = 0; r < R; ++r) { const float ms = s[r] * (1.f / DM) + EPS; const float rstd = rsqrtf(ms); u32x2* o8 = (u32x2*)(orow + (size_t)r * DM) + lane; if (lane == 0) rn[r] = ms * rstd;
#pragma unroll
        for (int j = 0; j < 4; ++j) { u32x2 w; w.x = pk2(v[r][j].x * rstd, v[r][j].y * rstd); w.y = pk2(v[r][j].z * rstd, v[r][j].w * rstd); o8[64 * j] = w; } }
}


template <int R, bool FINAL>
__device__ __forceinline__ void post_rows2(bf16_t* xb, float* rn, const bf16_t* frow, const float* gpost, float c, float* yout, int lane) {
    f32x4 f[R][4], v[R][4]; float s[R], rnv[R];
#pragma unroll
    for (int r = 0; r < R; ++r) { const u32x2* fr = (const u32x2*)(frow + (size_t)r * DM) + lane; const u32x2* xr = (const u32x2*)(xb + (size_t)r * DM) + lane; rnv[r] = rn[r];
#pragma unroll
        for (int j = 0; j < 4; ++j) { const u32x2 w = fr[64 * j]; f[r][j] = (f32x4){bflo(w.x), bfhi(w.x), bflo(w.y), bfhi(w.y)}; const u32x2 x = xr[64 * j]; v[r][j] = (f32x4){bflo(x.x), bfhi(x.x), bflo(x.y), bfhi(x.y)}; } }
    f32x4 g[4];
#pragma unroll
    for (int j = 0; j < 4; ++j) g[j] = ((const f32x4*)gpost + lane)[64 * j];
#pragma unroll
    for (int r = 0; r < R; ++r) { s[r] = 0.f;
#pragma unroll
        for (int j = 0; j < 4; ++j) s[r] += (f[r][j].x * f[r][j].x + f[r][j].y * f[r][j].y) + (f[r][j].z * f[r][j].z + f[r][j].w * f[r][j].w); }
#pragma unroll
    for (int o = 1; o < 64; o <<= 1) {
#pragma unroll
        for (int r = 0; r < R; ++r) s[r] += __shfl_xor(s[r], o); }
    float s2[R];
#pragma unroll
    for (int r = 0; r < R; ++r) { const float rf = c * rsqrtf(s[r] * (1.f / DM) + EPS); s2[r] = 0.f;
#pragma unroll
        for (int j = 0; j < 4; ++j) { v[r][j] = v[r][j] * rnv[r] + f[r][j] * rf * g[j]; s2[r] += (v[r][j].x * v[r][j].x + v[r][j].y * v[r][j].y) + (v[r][j].z * v[r][j].z + v[r][j].w * v[r][j].w); }
        if (FINAL) { f32x4* yo = (f32x4*)(yout + (size_t)r * DM) + lane;
#pragma unroll
            for (int j = 0; j < 4; ++j) yo[64 * j] = v[r][j]; } }
    if (!FINAL) {
#pragma unroll
        for (int o = 1; o < 64; o <<= 1) {
#pragma unroll
            for (int r = 0; r < R; ++r) s2[r] += __shfl_xor(s2[r], o); }
#pragma unroll
        for (int r = 0; r < R; ++r) { const float ms = s2[r] * (1.f / DM) + EPS; const float rstd = rsqrtf(ms); u32x2* o8 = (u32x2*)(xb + (size_t)r * DM) + lane;
#pragma unroll
            for (int j = 0; j < 4; ++j) { u32x2 w; w.x = pk2(v[r][j].x * rstd, v[r][j].y * rstd); w.y = pk2(v[r][j].z * rstd, v[r][j].w * rstd); o8[64 * j] = w; }
            if (lane == 0) rn[r] = ms * rstd; }
    }
}

constexpr int XS_OFF = 0, XS_P = 544;
constexpr int BS_OFF = 34816, RB_P = 288;
constexpr int CS_OFF = 53248;
constexpr int S_OFF = 71680, RC_P = 272;
constexpr int YS_OFF = 94208, YS_P = 528;
constexpr int TAB_OFF = 89088;
constexpr int MF_OFF = 94208;
static_assert(MF_OFF >= TAB_OFF + 4 * 1024 + 64 && MF_OFF + 24576 <= 131072, "ssd lds 2");
static_assert(YS_OFF + 64 * YS_P <= 131072 && S_OFF + 64 * RC_P <= TAB_OFF && TAB_OFF + 4 * 1024 + 64 <= 131072, "ssd lds");
typedef short s16x4 __attribute__((ext_vector_type(4)));
__device__ __forceinline__ bf16x8 tr_frag(const LAS unsigned char* p0, const LAS unsigned char* p1) {
    const s16x4 a = __builtin_amdgcn_ds_read_tr16_b64_v4i16((LAS s16x4*)p0), b = __builtin_amdgcn_ds_read_tr16_b64_v4i16((LAS s16x4*)p1);
    return __builtin_shufflevector(a, b, 0, 1, 2, 3, 4, 5, 6, 7);
}

__device__ __forceinline__ int crow(int reg, int h) { return (reg & 3) + 8 * (reg >> 2) + 4 * h; }
#define MFMA32(a, b, c) __builtin_amdgcn_mfma_f32_32x32x16_bf16((a), (b), (c), 0, 0, 0)

__device__ __forceinline__ void ssd_item(LAS unsigned char* lds, const bf16_t* XBC, bf16_t* ZY, const float* DT, int row0, int T, int g,
                                         const float* h0  , const float* convc  , float* ssm_out  ,
                                         const float* conv_w, const float* conv_b, const float* a_log, const float* d_skip) {
    const int tid = threadIdx.x, lane = tid & 63, wave = __builtin_amdgcn_readfirstlane(tid >> 6);
    const int hh = wave >> 1, ph = wave & 1, half = lane >> 5, r31 = lane & 31;
    const int cq = tid & 127, rq = wave >> 1, lc = 4 * cq;
    const int seg = lc < 256 ? 0 : (lc < 384 ? 1 : 2);
    const int col0 = seg == 0 ? 256 * g + lc : (seg == 1 ? 2048 + 128 * g + (lc - 256) : 3072 + 128 * g + (lc - 384));
    const int pitchA = seg == 0 ? XS_P : RB_P;
    LAS unsigned char* const pRM = lds + (seg == 0 ? XS_OFF + lc * 2 : (seg == 1 ? BS_OFF + (lc - 256) * 2 : CS_OFF + (lc - 384) * 2)) + 16 * rq * pitchA;
    const float a_h = -__expf(a_log[4 * g + hh]);
    const float a_scan = -__expf(a_log[4 * g + (wave & 3)]);
    const float Dh = d_skip[4 * g + hh];
    (void)a_h;
    f32x16 hT[4];
    {
        const float* hb = h0 ? h0 + ((size_t)hh * 64 + 32 * ph + r31) * 128 + 4 * half : nullptr;
#pragma unroll
        for (int nb = 0; nb < 4; ++nb)
#pragma unroll
            for (int q = 0; q < 4; ++q) { f32x4 v = {0.f, 0.f, 0.f, 0.f}; if (hb) v = *(const f32x4*)(hb + 32 * nb + 8 * q);
                hT[nb][4 * q] = v[0]; hT[nb][4 * q + 1] = v[1]; hT[nb][4 * q + 2] = v[2]; hT[nb][4 * q + 3] = v[3]; }
    }
    LAS unsigned char* const pYs = lds + YS_OFF + (4 * half) * YS_P + (64 * hh + 32 * ph + r31) * 2;
    const LAS unsigned char* const pCs = lds + CS_OFF + r31 * RB_P + (4 * half) * 2;
    const int trq = (lane & 15) >> 2, trp = lane & 3, trb = (lane >> 4) & 1;
    const LAS unsigned char* const pXf = lds + XS_OFF + (8 * half + trq) * XS_P + (64 * hh + 32 * ph + 16 * trb + 4 * trp) * 2;
    const LAS unsigned char* const pBt = lds + BS_OFF + (8 * half + trq) * RB_P + (16 * trb + 4 * trp) * 2;
    const LAS unsigned char* const pS = lds + S_OFF + r31 * RC_P + (8 * half) * 4;
    LAS float* dtL = (LAS float*)(lds + TAB_OFF); LAS float* acsL = dtL + 256; LAS float* eacsL = dtL + 512; LAS float* wL = dtL + 768; LAS float* eAL = dtL + 1024;
    const int nch = (T + 63) >> 6;
    {
        const int tA = 0, vA = T < 64 ? T : 64;
        u32x2 raw[19];
            const int rb = 16 * rq;
#pragma unroll
            for (int j = 0; j < 19; ++j) { const int t = tA + rb - 3 + j;
                raw[j] = (u32x2){0u, 0u};
                if (t >= 0 && t < T) raw[j] = *(const u32x2*)(XBC + (size_t)(row0 + t) * CONVD + col0); }
            const float dtvA = (wave < 4 && lane < vA) ? DT[(size_t)(row0 + tA + lane) * 32 + 4 * g + (wave & 3)] : 0.f;
            f32x4 cw[4];
#pragma unroll
            for (int k = 0; k < 4; ++k) cw[k] = *(const f32x4*)(conv_w + k * CONVD + col0);
            const f32x4 cb = *(const f32x4*)(conv_b + col0);
            f32x4 win0, win1, win2;
            { const u32x2 a = raw[0], b = raw[1], c2 = raw[2];
              win0 = (f32x4){bflo(a.x), bfhi(a.x), bflo(a.y), bfhi(a.y)}; win1 = (f32x4){bflo(b.x), bfhi(b.x), bflo(b.y), bfhi(b.y)}; win2 = (f32x4){bflo(c2.x), bfhi(c2.x), bflo(c2.y), bfhi(c2.y)};
              if (convc && tA + rb - 3 < 0) { win0 = *(const f32x4*)(convc + (tA + rb) * CONVD + col0); win1 = *(const f32x4*)(convc + (tA + rb + 1) * CONVD + col0); win2 = *(const f32x4*)(convc + (tA + rb + 2) * CONVD + col0); } }
#pragma unroll
            for (int r = 0; r < 16; r += 2) {
                const u32x2 wa = raw[r + 3], wb = raw[r + 4];
                const f32x4 win3 = {bflo(wa.x), bfhi(wa.x), bflo(wa.y), bfhi(wa.y)}, win4 = {bflo(wb.x), bfhi(wb.x), bflo(wb.y), bfhi(wb.y)};
                f32x4 o0 = cb + cw[0] * win0 + cw[1] * win1 + cw[2] * win2 + cw[3] * win3;
                f32x4 o1 = cb + cw[0] * win1 + cw[1] * win2 + cw[2] * win3 + cw[3] * win4;
                win0 = win2; win1 = win3; win2 = win4;
                o0 = silu4(o0); o1 = silu4(o1);
                if (vA < 64) { if (rb + r >= vA) o0 = (f32x4){0.f, 0.f, 0.f, 0.f}; if (rb + r + 1 >= vA) o1 = (f32x4){0.f, 0.f, 0.f, 0.f}; }
                *(LAS u32x2*)(pRM + r * pitchA) = (u32x2){pk2(o0[0], o0[1]), pk2(o0[2], o0[3])}; *(LAS u32x2*)(pRM + (r + 1) * pitchA) = (u32x2){pk2(o1[0], o1[1]), pk2(o1[2], o1[3])};
                __builtin_amdgcn_sched_barrier(0);
            }
        if (wave < 4) {
            const float dtv = dtvA;
            float cs = dtv;
#pragma unroll
            for (int o = 1; o < 64; o <<= 1) { const float t = __shfl_up(cs, o); if (lane >= o) cs += t; }
            const float acs = a_scan * cs; const float tot = __shfl(acs, 63);
            dtL[wave * 64 + lane] = dtv; acsL[wave * 64 + lane] = acs; eacsL[wave * 64 + lane] = __expf(acs); wL[wave * 64 + lane] = dtv * __expf(tot - acs);
            if (lane == 0) eAL[wave] = __expf(tot);
        }
    }
    __syncthreads();
    for (int c = 0; c < nch; ++c) {
        const int t0 = 64 * c; const int valid = (T - t0) < 64 ? (T - t0) : 64;
        int tl_ = threadIdx.x; asm volatile("" : "+v"(tl_));
        const int tid = tl_, lane = tid & 63, half = lane >> 5, r31 = lane & 31;
        const int cq = tid & 127, lc = 4 * cq;
        const int seg = lc < 256 ? 0 : (lc < 384 ? 1 : 2);
        const int col0 = seg == 0 ? 256 * g + lc : (seg == 1 ? 2048 + 128 * g + (lc - 256) : 3072 + 128 * g + (lc - 384));
        const int pitchA = seg == 0 ? XS_P : RB_P;
        LAS unsigned char* const pRM = lds + (seg == 0 ? XS_OFF + lc * 2 : (seg == 1 ? BS_OFF + (lc - 256) * 2 : CS_OFF + (lc - 384) * 2)) + 16 * rq * pitchA;
        LAS unsigned char* const pYs = lds + YS_OFF + (4 * half) * YS_P + (64 * hh + 32 * ph + r31) * 2;
        const LAS unsigned char* const pCs = lds + CS_OFF + r31 * RB_P + (4 * half) * 2;
        const int trq = (lane & 15) >> 2, trp = lane & 3, trb = (lane >> 4) & 1;
        const LAS unsigned char* const pXf = lds + XS_OFF + (8 * half + trq) * XS_P + (64 * hh + 32 * ph + 16 * trb + 4 * trp) * 2;
        const LAS unsigned char* const pBt = lds + BS_OFF + (8 * half + trq) * RB_P + (16 * trb + 4 * trp) * 2;
        const LAS unsigned char* const pS = lds + S_OFF + r31 * RC_P + (8 * half) * 4;
        {
            const int fr = lane & 15, fq = lane >> 4;
#pragma unroll
            for (int tt = 0; tt < 2; ++tt) { const int t = 2 * wave + tt, lt = t >> 2, st = t & 3;
                {
                    f32x4 sacc = {0.f, 0.f, 0.f, 0.f};
#pragma unroll
                    for (int ks = 0; ks < 4; ++ks) {
                        const bf16x8 af = *(const LAS bf16x8*)(lds + CS_OFF + (16 * lt + fr) * RB_P + (32 * ks + 8 * fq) * 2);
                        const bf16x8 bfr = *(const LAS bf16x8*)(lds + BS_OFF + (16 * st + fr) * RB_P + (32 * ks + 8 * fq) * 2);
                        sacc = __builtin_amdgcn_mfma_f32_16x16x32_bf16(af, bfr, sacc, 0, 0, 0);
                    }
#pragma unroll
                    for (int j = 0; j < 4; ++j) *(LAS float*)(lds + S_OFF + (16 * lt + 4 * fq + j) * RC_P + (16 * st + fr) * 4) = sacc[j];
                }
            }
        }
        __syncthreads();
#pragma unroll 1
        for (int it3 = 0; it3 < 3; ++it3) {
            const int fi = ph + 2 * it3;
            const int lt = fi >= 2 ? 1 : 0, ks = lt ? fi - 2 : fi;
            const int l = 32 * lt + r31; const float acs_l = acsL[hh * 64 + l];
            const int s0 = 16 * ks + 8 * half;
            const LAS float* sp = (const LAS float*)(pS + (32 * lt) * RC_P + (16 * ks) * 4);
            const f32x4 sv0 = *(const LAS f32x4*)sp, sv1 = *(const LAS f32x4*)(sp + 4);
            const f32x4 as0 = *(const LAS f32x4*)(acsL + hh * 64 + s0), as1 = *(const LAS f32x4*)(acsL + hh * 64 + s0 + 4);
            const f32x4 d0 = *(const LAS f32x4*)(dtL + hh * 64 + s0), d1 = *(const LAS f32x4*)(dtL + hh * 64 + s0 + 4);
            float mv[8];
            if (lt == 1 && ks < 2) {
#pragma unroll
                for (int j = 0; j < 8; ++j) { const float sv = j < 4 ? sv0[j & 3] : sv1[j & 3], as = j < 4 ? as0[j & 3] : as1[j & 3], dd = j < 4 ? d0[j & 3] : d1[j & 3];
                    mv[j] = sv * __expf(acs_l - as) * dd; }
            } else {
                const float dl0 = (float)(l - s0);
#pragma unroll
                for (int j = 0; j < 8; ++j) { const float sv = j < 4 ? sv0[j & 3] : sv1[j & 3], as = j < 4 ? as0[j & 3] : as1[j & 3], dd = j < 4 ? d0[j & 3] : d1[j & 3];
                    const float dl = dl0 - (float)j;
                    const float maskf = fminf(fmaxf(dl + 1.f, 0.f), 1.f);
                    const float diagf = fmaxf(1.f - fabsf(dl), 0.f);
                    mv[j] = sv * __expf(fminf(acs_l - as, 0.f)) * dd * maskf + Dh * diagf; }
            }
            u32x4 ap; ap.x = pk2(mv[0], mv[1]); ap.y = pk2(mv[2], mv[3]); ap.z = pk2(mv[4], mv[5]); ap.w = pk2(mv[6], mv[7]);
            *(LAS u32x4*)(lds + MF_OFF + ((hh * 6 + fi) * 64 + lane) * 16) = ap;
        }
        f32x16 y[2];
#pragma unroll
        for (int lt = 0; lt < 2; ++lt)
#pragma unroll
            for (int i = 0; i < 16; ++i) y[lt][i] = 0.f;
#pragma unroll
        for (int nb = 0; nb < 4; ++nb)
#pragma unroll
            for (int s = 0; s < 2; ++s) {
                u32x4 bp; bp.x = pk2(hT[nb][8 * s + 0], hT[nb][8 * s + 1]); bp.y = pk2(hT[nb][8 * s + 2], hT[nb][8 * s + 3]); bp.z = pk2(hT[nb][8 * s + 4], hT[nb][8 * s + 5]); bp.w = pk2(hT[nb][8 * s + 6], hT[nb][8 * s + 7]);
                const bf16x8 bfrag = __builtin_bit_cast(bf16x8, bp);
#pragma unroll
                for (int lt = 0; lt < 2; ++lt) {
                    const LAS unsigned char* cp = pCs + (32 * lt) * RB_P + (32 * nb + 16 * s) * 2;
                    const u32x2 lo = *(const LAS u32x2*)cp, hi = *(const LAS u32x2*)(cp + 16);
                    const bf16x8 afrag = __builtin_bit_cast(bf16x8, (u32x4){lo.x, lo.y, hi.x, hi.y});
                    y[lt] = MFMA32(afrag, bfrag, y[lt]);
                }
                __builtin_amdgcn_sched_barrier(0);
            }
#pragma unroll
        for (int lt = 0; lt < 2; ++lt)
#pragma unroll
            for (int q = 0; q < 4; ++q) { const f32x4 e = *(const LAS f32x4*)(eacsL + hh * 64 + 32 * lt + 8 * q + 4 * half);
#pragma unroll
                for (int j = 0; j < 4; ++j) y[lt][4 * q + j] *= e[j]; }
        bf16x8 xf[4];
#pragma unroll
        for (int ks = 0; ks < 4; ++ks) xf[ks] = tr_frag(pXf + (16 * ks) * XS_P, pXf + (16 * ks + 4) * XS_P);
        __syncthreads();
#pragma unroll
        for (int fi = 0; fi < 6; ++fi) { const int lt = fi >= 2 ? 1 : 0, ks = lt ? fi - 2 : fi;
            const bf16x8 mf = *(const LAS bf16x8*)(lds + MF_OFF + ((hh * 6 + fi) * 64 + lane) * 16);
            y[lt] = MFMA32(mf, xf[ks], y[lt]); }
        __syncthreads();
#pragma unroll
        for (int lt = 0; lt < 2; ++lt)
#pragma unroll
            for (int i = 0; i < 16; ++i)
                *(LAS bf16_t*)(pYs + (32 * lt + (i & 3) + 8 * (i >> 2)) * YS_P) = (bf16_t)(pk2(y[lt][i], 0.f) & 0xffffu);
        const int nl = tid >> 3, npart = tid & 7;
        u32x4 zr[4];
        {
            const bf16_t* zp = ZY + (size_t)(row0 + t0 + (nl < valid ? nl : 0)) * DINNER + 256 * g + 32 * npart;
#pragma unroll
            for (int q = 0; q < 4; ++q) zr[q] = *(const u32x4*)(zp + 8 * q);
        }
        {
            const float eA = eAL[hh];
#pragma unroll
            for (int nb = 0; nb < 4; ++nb)
#pragma unroll
                for (int i = 0; i < 16; ++i) hT[nb][i] *= eA;
            bf16x8 xw[4];
#pragma unroll
            for (int ks = 0; ks < 4; ++ks) { const u32x4 xr = __builtin_bit_cast(u32x4, xf[ks]);
                const f32x4 w0 = *(const LAS f32x4*)(wL + hh * 64 + 16 * ks + 8 * half), w1 = *(const LAS f32x4*)(wL + hh * 64 + 16 * ks + 8 * half + 4);
                u32x4 o; o.x = pk2(bflo(xr.x) * w0[0], bfhi(xr.x) * w0[1]); o.y = pk2(bflo(xr.y) * w0[2], bfhi(xr.y) * w0[3]); o.z = pk2(bflo(xr.z) * w1[0], bfhi(xr.z) * w1[1]); o.w = pk2(bflo(xr.w) * w1[2], bfhi(xr.w) * w1[3]);
                xw[ks] = __builtin_bit_cast(bf16x8, o); }
#pragma unroll
            for (int nb = 0; nb < 4; ++nb)
#pragma unroll
                for (int ks = 0; ks < 4; ++ks) {
                    const bf16x8 af = tr_frag(pBt + (16 * ks) * RB_P + 64 * nb, pBt + (16 * ks + 4) * RB_P + 64 * nb);
                    hT[nb] = MFMA32(af, xw[ks], hT[nb]);
                }
        }
        __syncthreads();
        const bool nxtc = c + 1 < nch; const int tA = t0 + 64, vA = (T - tA) < 64 ? (T - tA) : 64; const int rb = 16 * rq;
        u32x2 raw[19]; float dtvA = 0.f;
        if (nxtc) {
#pragma unroll
            for (int j = 0; j < 19; ++j) { const int t = tA + rb - 3 + j;
                raw[j] = (u32x2){0u, 0u};
                if (t >= 0 && t < T) raw[j] = *(const u32x2*)(XBC + (size_t)(row0 + t) * CONVD + col0); }
            if (wave < 4 && lane < vA) dtvA = DT[(size_t)(row0 + tA + lane) * 32 + 4 * g + (wave & 3)];
        }
        __builtin_amdgcn_sched_barrier(0);
        {
            float gv[32]; float ss = 0.f;
#pragma unroll
            for (int q = 0; q < 4; ++q) { const u32x4 yv = *(const LAS u32x4*)(lds + YS_OFF + nl * YS_P + npart * 64 + q * 16);
                const f32x4 za = {bflo(zr[q].x), bfhi(zr[q].x), bflo(zr[q].y), bfhi(zr[q].y)}, zb = {bflo(zr[q].z), bfhi(zr[q].z), bflo(zr[q].w), bfhi(zr[q].w)};
                const f32x4 ya = {bflo(yv.x), bfhi(yv.x), bflo(yv.y), bfhi(yv.y)}, yb = {bflo(yv.z), bfhi(yv.z), bflo(yv.w), bfhi(yv.w)};
                const f32x4 ga = ya * pg8::silu4(za), gb = yb * pg8::silu4(zb);
#pragma unroll
                for (int e = 0; e < 4; ++e) { gv[8 * q + e] = ga[e]; gv[8 * q + 4 + e] = gb[e]; ss += ga[e] * ga[e] + gb[e] * gb[e]; } }
            ss += __shfl_xor(ss, 1); ss += __shfl_xor(ss, 2); ss += __shfl_xor(ss, 4);
            const float rstd = rsqrtf(ss * (1.f / 256.f) + EPS);
            if (nl < valid) {
                bf16_t* op = ZY + (size_t)(row0 + t0 + nl) * DINNER + 256 * g + 32 * npart;
#pragma unroll
                for (int q = 0; q < 4; ++q) { u32x4 o; o.x = pk2(gv[8 * q] * rstd, gv[8 * q + 1] * rstd); o.y = pk2(gv[8 * q + 2] * rstd, gv[8 * q + 3] * rstd); o.z = pk2(gv[8 * q + 4] * rstd, gv[8 * q + 5] * rstd); o.w = pk2(gv[8 * q + 6] * rstd, gv[8 * q + 7] * rstd);
                    *(u32x4*)(op + 8 * q) = o; }
            }
        }
        __builtin_amdgcn_sched_barrier(0);
        if (nxtc) {
            f32x4 cw[4];
#pragma unroll
            for (int k = 0; k < 4; ++k) cw[k] = *(const f32x4*)(conv_w + k * CONVD + col0);
            const f32x4 cb = *(const f32x4*)(conv_b + col0);
            f32x4 win0, win1, win2;
            { const u32x2 a = raw[0], b = raw[1], c2 = raw[2];
              win0 = (f32x4){bflo(a.x), bfhi(a.x), bflo(a.y), bfhi(a.y)}; win1 = (f32x4){bflo(b.x), bfhi(b.x), bflo(b.y), bfhi(b.y)}; win2 = (f32x4){bflo(c2.x), bfhi(c2.x), bflo(c2.y), bfhi(c2.y)};
              if (convc && tA + rb - 3 < 0) { win0 = *(const f32x4*)(convc + (tA + rb) * CONVD + col0); win1 = *(const f32x4*)(convc + (tA + rb + 1) * CONVD + col0); win2 = *(const f32x4*)(convc + (tA + rb + 2) * CONVD + col0); } }
#pragma unroll
            for (int r = 0; r < 16; r += 2) {
                const u32x2 wa = raw[r + 3], wb = raw[r + 4];
                const f32x4 win3 = {bflo(wa.x), bfhi(wa.x), bflo(wa.y), bfhi(wa.y)}, win4 = {bflo(wb.x), bfhi(wb.x), bflo(wb.y), bfhi(wb.y)};
                f32x4 o0 = cb + cw[0] * win0 + cw[1] * win1 + cw[2] * win2 + cw[3] * win3;
                f32x4 o1 = cb + cw[0] * win1 + cw[1] * win2 + cw[2] * win3 + cw[3] * win4;
                win0 = win2; win1 = win3; win2 = win4;
                o0 = silu4(o0); o1 = silu4(o1);
                if (vA < 64) { if (rb + r >= vA) o0 = (f32x4){0.f, 0.f, 0.f, 0.f}; if (rb + r + 1 >= vA) o1 = (f32x4){0.f, 0.f, 0.f, 0.f}; }
                *(LAS u32x2*)(pRM + r * pitchA) = (u32x2){pk2(o0[0], o0[1]), pk2(o0[2], o0[3])}; *(LAS u32x2*)(pRM + (r + 1) * pitchA) = (u32x2){pk2(o1[0], o1[1]), pk2(o1[2], o1[3])};
                __builtin_amdgcn_sched_barrier(0);
            }
        if (wave < 4) {
            const float dtv = dtvA;
            float cs = dtv;
#pragma unroll
            for (int o = 1; o < 64; o <<= 1) { const float t = __shfl_up(cs, o); if (lane >= o) cs += t; }
            const float acs = a_scan * cs; const float tot = __shfl(acs, 63);
            dtL[wave * 64 + lane] = dtv; acsL[wave * 64 + lane] = acs; eacsL[wave * 64 + lane] = __expf(acs); wL[wave * 64 + lane] = dtv * __expf(tot - acs);
            if (lane == 0) eAL[wave] = __expf(tot);
        }
        }
        __syncthreads();
    }
    {
        float* sb = ssm_out + ((size_t)hh * 64 + 32 * ph + r31) * 128 + 4 * half;
#pragma unroll
        for (int nb = 0; nb < 4; ++nb)
#pragma unroll
            for (int q = 0; q < 4; ++q) *(f32x4*)(sb + 32 * nb + 8 * q) = (f32x4){hT[nb][4 * q], hT[nb][4 * q + 1], hT[nb][4 * q + 2], hT[nb][4 * q + 3]};
    }
}

__device__ __forceinline__ void load8(const bf16_t* p, float (&v)[8]) { const u32x4 w = *(const u32x4*)p; v[0] = bflo(w.x); v[1] = bfhi(w.x); v[2] = bflo(w.y); v[3] = bfhi(w.y); v[4] = bflo(w.z); v[5] = bfhi(w.z); v[6] = bflo(w.w); v[7] = bfhi(w.w); }
__device__ __forceinline__ void pool_task(const bf16_t* U, bf16_t* PL, int row0, int T, int t0, int hsel, int pos0, const float* cache  , int lane) {
    const int o = hsel * 64 + lane, col = 8 * o, gi = o >> 5, k = 2 << gi;
    float ws[8];
#pragma unroll
    for (int i = 0; i < 8; ++i) ws[i] = 0.f;
    for (int j = 1; j < k; ++j) { const int t = t0 - j; float v[8];
        if (t >= 0) { load8(U + (size_t)(row0 + t) * DM + col, v); }
        else if (cache) { const f32x4 a = *(const f32x4*)(cache + (15 + t) * DM + col), b = *(const f32x4*)(cache + (15 + t) * DM + col + 4); v[0] = a[0]; v[1] = a[1]; v[2] = a[2]; v[3] = a[3]; v[4] = b[0]; v[5] = b[1]; v[6] = b[2]; v[7] = b[3]; }
        else {
#pragma unroll
            for (int i = 0; i < 8; ++i) v[i] = 0.f; }
#pragma unroll
        for (int i = 0; i < 8; ++i) ws[i] += v[i]; }
    const int nr = (T - t0) < 64 ? (T - t0) : 64;
    for (int r0 = 0; r0 < nr; r0 += 8) {
        u32x4 cu[8], ol[8];
#pragma unroll
        for (int r = 0; r < 8; ++r) { const int t = t0 + r0 + r, to = t - k + 1;
            cu[r] = *(const u32x4*)(U + (size_t)(row0 + t) * DM + col);
            ol[r] = (u32x4){0u, 0u, 0u, 0u};
            if (to >= 0) ol[r] = *(const u32x4*)(U + (size_t)(row0 + to) * DM + col); }
#pragma unroll
        for (int r = 0; r < 8; ++r) { const int t = t0 + r0 + r, to = t - k + 1;
            float cur[8] = {bflo(cu[r].x), bfhi(cu[r].x), bflo(cu[r].y), bfhi(cu[r].y), bflo(cu[r].z), bfhi(cu[r].z), bflo(cu[r].w), bfhi(cu[r].w)};
            float old[8] = {bflo(ol[r].x), bfhi(ol[r].x), bflo(ol[r].y), bfhi(ol[r].y), bflo(ol[r].z), bfhi(ol[r].z), bflo(ol[r].w), bfhi(ol[r].w)};
            if (to < 0 && cache) { const f32x4 a = *(const f32x4*)(cache + (15 + to) * DM + col), b = *(const f32x4*)(cache + (15 + to) * DM + col + 4); old[0] = a[0]; old[1] = a[1]; old[2] = a[2]; old[3] = a[3]; old[4] = b[0]; old[5] = b[1]; old[6] = b[2]; old[7] = b[3]; }
            const int pc = pos0 + t + 1; const float inv = 1.0f / (float)(pc < k ? pc : k);
            float pv[8];
#pragma unroll
            for (int i = 0; i < 8; ++i) { ws[i] += cur[i]; pv[i] = ws[i] * inv - cur[i]; ws[i] -= old[i]; }
            u32x4 w; w.x = pk2(pv[0], pv[1]); w.y = pk2(pv[2], pv[3]); w.z = pk2(pv[4], pv[5]); w.w = pk2(pv[6], pv[7]);
            *(u32x4*)(PL + (size_t)(row0 + t) * DM + col) = w; }
    }
}

enum { SM_SWIGLU = 0, SM_BF16 = 1, SM_WIN1 = 2, SM_WIN2 = 3, SM_GATE0 = 4, SM_GATE1 = 5 };
constexpr int SMR_P = 36, SMT_OFF = 8 * 32 * SMR_P * 4, SMT_P = 33;
template <int MODE>
__device__ __forceinline__ void small_gemm(LAS unsigned char* lds, const bf16_t* A, const bf16_t* Bt, int N, int K,
                                           bf16_t* O0, bf16_t* O1, float* OF, const float* bias) {
    int tid_ = threadIdx.x; asm volatile("" : "+v"(tid_));
    const int tid = tid_, lane = tid & 63, wave = __builtin_amdgcn_readfirstlane(tid >> 6), r31 = lane & 31, half = lane >> 5;
    const int ntiles = 4 * (N >> 5), ksl = K >> 3, nsteps = ksl >> 4;
    LAS float* red = (LAS float*)lds; LAS float* tile = (LAS float*)(lds + SMT_OFF);
    for (int t = blockIdx.x; t < ntiles; t += gridDim.x) {
        const int mq = t & 3, n0 = (t >> 2) << 5;
        const bf16_t* bp = Bt + (size_t)(n0 + r31) * K + wave * ksl + 8 * half;
        const bf16_t* ap = A + (size_t)(32 * mq + r31) * K + wave * ksl + 8 * half;
        f32x16 acc;
#pragma unroll
        for (int i = 0; i < 16; ++i) acc[i] = 0.f;
#pragma unroll 8
        for (int s = 0; s < nsteps; ++s) {
            const bf16x8 bfr = *(const bf16x8*)(bp + 16 * s), afr = *(const bf16x8*)(ap + 16 * s);
            acc = MFMA32(bfr, afr, acc);
        }
#pragma unroll
        for (int q = 0; q < 4; ++q) *(LAS f32x4*)(red + (wave * 32 + r31) * SMR_P + 8 * q + 4 * half) = (f32x4){acc[4 * q], acc[4 * q + 1], acc[4 * q + 2], acc[4 * q + 3]};
        __syncthreads();
        { const int m = tid >> 4, n = 2 * (tid & 15); float s0 = 0.f, s1 = 0.f;
#pragma unroll
          for (int w = 0; w < 8; ++w) { s0 += red[(w * 32 + m) * SMR_P + n]; s1 += red[(w * 32 + m) * SMR_P + n + 1]; }
          tile[m * SMT_P + n] = s0; tile[m * SMT_P + n + 1] = s1; }
        __syncthreads();
        {
            const int m = tid >> 4, j = tid & 15, n = 2 * j; const size_t row = (size_t)MP + 32 * mq + m;
            if (MODE == SM_SWIGLU) {
                const int pn = n0 >> 8, c0 = n0 & 255, bj = c0 >> 7, wc = (c0 >> 5) & 3;
                const int h = 128 * pn + 32 * wc + 8 * (j >> 2) + 4 * bj + (j & 3);
                const float g = tile[m * SMT_P + j], u = tile[m * SMT_P + 16 + j];
                O0[row * DFF + h] = (bf16_t)(pk2(fast_silu(g) * u, 0.f) & 0xffffu);
            } else {
                float v0 = tile[m * SMT_P + n], v1 = tile[m * SMT_P + n + 1]; const int np = n0 + n;
                if (MODE == SM_BF16) { *(unsigned*)(O0 + row * DM + np) = pk2(v0, v1); }
                if (MODE == SM_WIN1) {
                    if (np < 2048) *(unsigned*)(O0 + row * 2048 + np) = pk2(v0, v1);
                    else if (np < 6144) *(unsigned*)(O1 + row * 4096 + (np - 2048)) = pk2(v0, v1);
                    else { const int c = np - 6144; v0 += bias[c]; v1 += bias[c + 1];
                        OF[row * 32 + c] = fmaxf(v0, 0.f) + log1pf(expf(-fabsf(v0))); OF[row * 32 + c + 1] = fmaxf(v1, 0.f) + log1pf(expf(-fabsf(v1))); }
                }
                if (MODE == SM_WIN2) { const int tt = np >> 10; if (tt) { v0 = fast_sigmoid(v0); v1 = fast_sigmoid(v1); }
                    *(unsigned*)(O0 + (size_t)tt * MT * 1024 + row * DM + (np & 1023)) = pk2(v0, v1); }
                if (MODE == SM_GATE0) { unsigned* p = (unsigned*)(O0 + row * DM + np); const unsigned g = *p; *p = pk2(bflo(g) * v0, bfhi(g) * v1); }
                if (MODE == SM_GATE1) { unsigned* p = (unsigned*)(O0 + row * DM + np); const unsigned g = *p, tt = *(const unsigned*)(O1 + row * DM + np);
                    *p = pk2(bflo(tt) + bflo(g) * v0, bfhi(tt) + bfhi(g) * v1); }
            }
        }
    }
    __syncthreads();
}


constexpr int SM16_P = 20;
template <int MODE>
__device__ __forceinline__ void small_gemm16(LAS unsigned char* lds, const bf16_t* A, const bf16_t* Bt, int K, bf16_t* O0, const bf16_t* O1) {
    int tid_ = threadIdx.x; asm volatile("" : "+v"(tid_));
    const int tid = tid_, lane = tid & 63, wave = __builtin_amdgcn_readfirstlane(tid >> 6), r15 = lane & 15, kq = lane >> 4;
    const int ksl = K >> 3, nsteps = ksl >> 5;
    LAS float* red = (LAS float*)lds;
    for (int t = blockIdx.x; t < 256; t += gridDim.x) {
        const int mq = t & 3, n0 = (t >> 2) << 4;
        const bf16_t* bp = Bt + (size_t)(n0 + r15) * K + wave * ksl + 8 * kq;
        const bf16_t* ap = A + (size_t)(32 * mq + r15) * K + wave * ksl + 8 * kq;
        f32x4 acc0 = {0.f, 0.f, 0.f, 0.f}, acc1 = {0.f, 0.f, 0.f, 0.f};
#pragma unroll 4
        for (int s = 0; s < nsteps; ++s) {
            const bf16x8 bfr = *(const bf16x8*)(bp + 32 * s), a0 = *(const bf16x8*)(ap + 32 * s), a1 = *(const bf16x8*)(ap + (size_t)16 * K + 32 * s);
            acc0 = __builtin_amdgcn_mfma_f32_16x16x32_bf16(bfr, a0, acc0, 0, 0, 0);
            acc1 = __builtin_amdgcn_mfma_f32_16x16x32_bf16(bfr, a1, acc1, 0, 0, 0);
        }
        *(LAS f32x4*)(red + (wave * 32 + r15) * SM16_P + 4 * kq) = acc0;
        *(LAS f32x4*)(red + (wave * 32 + 16 + r15) * SM16_P + 4 * kq) = acc1;
        __syncthreads();
        {
            const int m = tid >> 4, n = tid & 15; float v = 0.f;
#pragma unroll
            for (int w = 0; w < 8; ++w) v += red[(w * 32 + m) * SM16_P + n];
            const size_t idx = ((size_t)MP + 32 * mq + m) * DM + n0 + n;
            if (MODE == SM_BF16) O0[idx] = (bf16_t)(pk2(v, 0.f) & 0xffffu);
            if (MODE == SM_GATE0) O0[idx] = (bf16_t)(pk2(bflo((unsigned)O0[idx]) * v, 0.f) & 0xffffu);
            if (MODE == SM_GATE1) O0[idx] = (bf16_t)(pk2(bflo((unsigned)O1[idx]) + bflo((unsigned)O0[idx]) * v, 0.f) & 0xffffu);
        }
        __syncthreads();
    }
}

#define RLX_AGENT __ATOMIC_RELAXED, __HIP_MEMORY_SCOPE_AGENT
#define XB_TMO      128
#define XB_XCNT(j)  (256  + 64 * (j))
#define XB_XSUB(j)  (1280 + 64 * (j))
#define XB_XGEN(j)  (2304 + 64 * (j))
#define XB_TOP      3328
#define XB_TOPGEN   3392
#define XCD_BAR_WORDS 3456
#define XB_SPIN_CAP (1u << 18)

__device__ __forceinline__ unsigned xb_ld(unsigned* p)              { return __hip_atomic_load(p, __ATOMIC_RELAXED, __HIP_MEMORY_SCOPE_AGENT); }
__device__ __forceinline__ unsigned xb_add(unsigned* p, unsigned v) { return __hip_atomic_fetch_add(p, v, __ATOMIC_RELAXED, __HIP_MEMORY_SCOPE_AGENT); }
__device__ __forceinline__ unsigned xb_xcc_id() { return (unsigned)__builtin_amdgcn_s_getreg((3 << 11) | 20) & 0xFu; }
#define XB_SPIN(cond, bar) do { unsigned _sp = 0; while (cond) { __builtin_amdgcn_s_sleep(1); \
    if ((++_sp & 255u) == 0u) { if (xb_ld(&(bar)[XB_TMO])) break; if (_sp > XB_SPIN_CAP) { atomicAdd(&(bar)[XB_TMO], 1u); break; } } } } while (0)

struct XcdBarrier {
    unsigned* bar; unsigned x;
    volatile LAS unsigned* st;
};

__device__ __forceinline__ XcdBarrier xcd_barrier_post(unsigned* bar, volatile LAS unsigned* st) {
    XcdBarrier b; b.bar = bar; b.x = xb_xcc_id(); b.st = st;
    if (threadIdx.x == 0) (void)xb_add(&bar[XB_XCNT(b.x)], 1u);
    return b;
}
__device__ __forceinline__ void xcd_barrier_complete(unsigned* bar, unsigned x, unsigned& nloc, unsigned& nx) {
    const unsigned G = gridDim.x * gridDim.y * gridDim.z;
    unsigned sum, cnt, mine, sp = 0u;
    for (;;) {
        sum = 0u; cnt = 0u; mine = 0u;
#pragma unroll
        for (unsigned j = 0; j < 16; ++j) { const unsigned c = xb_ld(&bar[XB_XCNT(j)]); sum += c; cnt += (c > 0u) ? 1u : 0u; mine = (j == x) ? c : mine; }
        if (sum == G) break;
        __builtin_amdgcn_s_sleep(1);
        if ((++sp & 255u) == 0u) { if (xb_ld(&bar[XB_TMO])) break; if (sp > XB_SPIN_CAP) { atomicAdd(&bar[XB_TMO], 1u); break; } }
    }
    nloc = mine > 0u ? mine : 1u; nx = cnt > 0u ? cnt : 1u;
}

__device__ __forceinline__ void xcd_barrier(const XcdBarrier& b) {
    asm volatile("s_waitcnt vmcnt(0)" ::: "memory");
    __syncthreads();
    if (threadIdx.x == 0) {
        unsigned* bar = b.bar;
        __builtin_amdgcn_s_waitcnt(0);
        unsigned nloc = b.st[0], nx = b.st[1];
        if (nloc == 0u) { xcd_barrier_complete(bar, b.x, nloc, nx); b.st[0] = nloc; b.st[1] = nx; }
        const unsigned old = xb_add(&bar[XB_XSUB(b.x)], 1u);
        const unsigned gen = old / nloc;
        if (old + 1u == (gen + 1u) * nloc) {
            __builtin_amdgcn_fence(__ATOMIC_RELEASE, "agent");
            asm volatile("s_waitcnt vmcnt(0)" ::: "memory");
            const unsigned og = xb_add(&bar[XB_TOP], 1u);
            const unsigned tg = og / nx;
            if (og + 1u == (tg + 1u) * nx) xb_add(&bar[XB_TOPGEN], 1u);
            else XB_SPIN(xb_ld(&bar[XB_TOPGEN]) == tg, bar);
            __builtin_amdgcn_fence(__ATOMIC_ACQUIRE, "agent");
            xb_add(&bar[XB_XGEN(b.x)], 1u);
            asm volatile("s_waitcnt vmcnt(0)" ::: "memory");
        } else {
            XB_SPIN(xb_ld(&bar[XB_XGEN(b.x)]) == gen, bar);
            __builtin_amdgcn_fence(__ATOMIC_ACQUIRE, "agent");
            asm volatile("s_waitcnt vmcnt(0)" ::: "memory");
        }
    }
    __syncthreads();
}

struct Params { const float* in[29]; float* out; unsigned char* ws; };
#define KAS __attribute__((address_space(4)))
__device__ __forceinline__ const KAS unsigned char* kargs() { const KAS unsigned char* p = (const KAS unsigned char*)__builtin_amdgcn_kernarg_segment_ptr(); asm volatile("" : "+s"(p)); return p; }
#define KIN(i) (*(const float* const KAS*)(kargs() + 8 * (i)))
#define KOUT (*(float* const KAS*)(kargs() + 232))
#define KWS (*(unsigned char* const KAS*)(kargs() + 240))
#define WSP(off) ((bf16_t*)(KWS + (off)))
constexpr int XB_ST_OFF = 131072 + 320;
#define XBAR_POST() do { (void)xcd_barrier_post((unsigned*)KWS, (volatile LAS unsigned*)(lds + XB_ST_OFF)); } while (0)
#define XBAR() do { XcdBarrier b_; b_.bar = (unsigned*)KWS; b_.x = xb_xcc_id(); b_.st = (volatile LAS unsigned*)(lds + XB_ST_OFF); xcd_barrier(b_); } while (0)

__global__ void __launch_bounds__(NTHREADS, 2) hybrid_fwd(Params Pdummy) {
    extern __shared__ __attribute__((aligned(16))) unsigned char lds_raw[];
    LAS unsigned char* lds = (LAS unsigned char*)lds_raw;
    cg::grid_group grid = cg::this_grid();
#define TID ((int)threadIdx.x)
#define LANE (TID & 63)
#define WAVE (__builtin_amdgcn_readfirstlane(TID >> 6))
#define GW ((int)blockIdx.x * NWAVES + WAVE)
#define NGW ((int)gridDim.x * NWAVES)
    constexpr size_t R2S = (size_t)MT * 1024 * 2;

    if (TID < 2) ((volatile LAS unsigned*)(lds + XB_ST_OFF))[TID] = 0u;
    if (blockIdx.x == 0) { unsigned* bw = (unsigned*)KWS; for (int i = TID; i < XCD_BAR_WORDS; i += NTHREADS) bw[i] = 0u; }
    {
        const int lane = LANE, wave = WAVE, gw = GW, ngw = NGW;
        LAS float* scr = (LAS float*)(lds + wave * 8448);
        constexpr int I_GU = 16 * 176, I_D = 44 * 32, I_IN = 16 * 296, I_PS = 32 * 32, I_O = 16 * 32;
        constexpr int NITEMS = 2 * (I_GU + I_D) + I_IN + I_PS + I_O;
        for (int it = gw; it < NITEMS; it += ngw) {
            int r = it;
            if (r < I_GU) { wt_item<1>(KIN(7), KIN(8), DFF, DM, KIN(5), WSP(WS_WGU1), 176, scr, r, lane); continue; } r -= I_GU;
            if (r < I_D) { wt_item<0>(KIN(9), nullptr, DM, DFF, nullptr, WSP(WS_WD1), 32, scr, r, lane); continue; } r -= I_D;
            if (r < I_IN) { wt_item<2>(KIN(12), nullptr, 9248, DM, KIN(10), WSP(WS_WIN), 296, scr, r, lane); continue; } r -= I_IN;
            if (r < I_PS) { wt_item<0>(KIN(19), nullptr, DM, DINNER, KIN(18), WSP(WS_WPS), 32, scr, r, lane); continue; } r -= I_PS;
            if (r < I_O) { wt_item<0>(KIN(23), nullptr, DM, DM, nullptr, WSP(WS_WOUT), 32, scr, r, lane); continue; } r -= I_O;
            if (r < I_GU) { wt_item<1>(KIN(26), KIN(27), DFF, DM, KIN(24), WSP(WS_WGU2), 176, scr, r, lane); continue; } r -= I_GU;
            wt_item<0>(KIN(28), nullptr, DM, DFF, nullptr, WSP(WS_WD2), 32, scr, r, lane);
        }
        { const float* mix = KIN(20); const float* sc = KIN(21); const float* wpp = KIN(22); bf16_t* wc = WSP(WS_WCOMB);
          for (int t = gw; t < 2048; t += ngw) wcomb_task(mix, sc, wpp, wc, t, lane); }
        { const float* xp = KIN(0); const float* xs = KIN(1); bf16_t* XB = WSP(WS_XB);
          for (int m = 4 * gw; m < MV; m += 4 * ngw) norm_rows_to_bf16<4>(m < MP ? xp + (size_t)m * DM : xs + (size_t)(m - MP) * DM, XB + (size_t)m * DM, (float*)(KWS + WS_RN) + m, lane); }
    }
    grid.sync();
    XBAR_POST();
    small_gemm<SM_SWIGLU>(lds, WSP(WS_XB) + (size_t)MP * DM, WSP(WS_WGU1), 2 * DFF, DM, WSP(WS_R2), nullptr, nullptr, nullptr);
    { pg8::Gemm g{WSP(WS_XB), WSP(WS_WGU1), MP, 2 * DFF, DM}; pg8::StaticOrder S; S.init(MP, 2 * DFF, gridDim.x, blockIdx.x); pg8::EpiSwiglu E{WSP(WS_R2), DFF};
      pg8::gemm_phase<pg8::EpiSwiglu, pg8::StaticOrder, true, true>(lds, g, S, E); }
    XBAR();
    small_gemm16<SM_BF16>(lds, WSP(WS_R2) + (size_t)MP * DFF, WSP(WS_WD1), DFF, WSP(WS_R1), nullptr);
    { pg8::Gemm g{WSP(WS_R2), WSP(WS_WD1), MP, DM, DFF, 1}; pg8::StaticOrder S; S.init(MP, DM, gridDim.x, blockIdx.x); pg8::EpiBf16 E{WSP(WS_R1), DM};
      pg8::gemm_phase<pg8::EpiBf16, pg8::StaticOrder, true, true>(lds, g, S, E); }
    XBAR();
    { const int lane = LANE, gw = GW, ngw = NGW; const float* gp = KIN(6); const bf16_t* F = WSP(WS_R1); bf16_t* XB = WSP(WS_XB); float* RN = (float*)(KWS + WS_RN);
      for (int m = 4 * gw; m < MV; m += 4 * ngw) post_rows2<4, false>(XB + (size_t)m * DM, RN + m, F + (size_t)m * DM, gp, 0.5f, nullptr, lane); }
    XBAR();
    small_gemm<SM_WIN1>(lds, WSP(WS_XB) + (size_t)MP * DM, WSP(WS_WIN), 6176, DM, WSP(WS_R1), WSP(WS_R2), (float*)(KWS + WS_DT), KIN(15));
    { pg8::Gemm g{WSP(WS_XB), WSP(WS_WIN), MP, NWIN1, DM}; pg8::StaticOrder S; S.init(MP, NWIN1, gridDim.x, blockIdx.x); pg8::EpiWin1 E{WSP(WS_R1), WSP(WS_R2), (float*)(KWS + WS_DT), KIN(15)};
      pg8::gemm_phase<pg8::EpiWin1, pg8::StaticOrder, true, true>(lds, g, S, E); }
    XBAR();
    {
        const int G = gridDim.x, bid = blockIdx.x;
        const bf16_t* XBC = WSP(WS_R2); bf16_t* ZY = WSP(WS_R1); const float* DT = (const float*)(KWS + WS_DT); float* out = KOUT;
        for (int it = bid; it < 256 + 64; it += G) {
            const bool smp = it >= 256; const int b = (smp ? it - 256 : it) >> 3, g = it & 7;
            const float* h0 = smp ? KIN(3) + ((size_t)b * 32 + 4 * g) * 8192 : nullptr;
            const float* cc = smp ? KIN(2) + (size_t)b * 3 * CONVD : nullptr;
            float* so = out + (smp ? O_SSMS : O_SSMP) + ((size_t)b * 32 + 4 * g) * 8192;
            ssd_item(lds, XBC, ZY, DT, smp ? MP + b * SSEQ : b * SEQ, smp ? SSEQ : SEQ, g, h0, cc, so, KIN(13), KIN(14), KIN(16), KIN(17));
        }
        for (int i = bid * NTHREADS + TID; i < 40 * 3 * 1024; i += G * NTHREADS) {
            const int c4 = i & 1023, r = (i >> 10) % 3, s = i / 3072;
            const int row = s < 32 ? s * SEQ + SEQ - 3 + r : MP + (s - 32) * SSEQ + SSEQ - 3 + r;
            const u32x2 w = *(const u32x2*)(XBC + (size_t)row * CONVD + 4 * c4);
            float* dst = s < 32 ? out + O_CONVP + ((size_t)s * 3 + r) * CONVD + 4 * c4 : out + O_CONVS + ((size_t)(s - 32) * 3 + r) * CONVD + 4 * c4;
            *(f32x4*)dst = (f32x4){bflo(w.x), bfhi(w.x), bflo(w.y), bfhi(w.y)};
        }
    }
    XBAR();
    small_gemm<SM_WIN2>(lds, WSP(WS_XB) + (size_t)MP * DM, WSP(WS_WIN + (size_t)NWIN1 * DM * 2), 3072, DM, WSP(WS_R2), nullptr, nullptr, nullptr);
    { pg8::Gemm g{WSP(WS_XB), WSP(WS_WIN + (size_t)NWIN1 * DM * 2), MP, 3072, DM}; pg8::StaticOrder S; S.init(MP, 3072, gridDim.x, blockIdx.x); pg8::EpiWin2 E{WSP(WS_R2), (size_t)MT * 1024};
      pg8::gemm_phase<pg8::EpiWin2, pg8::StaticOrder, true, true>(lds, g, S, E); }
    XBAR();
    {
        const int lane = LANE, gw = GW, ngw = NGW;
        const bf16_t* U = WSP(WS_R2); bf16_t* PL = WSP(WS_R2 + 3 * R2S); float* out = KOUT; const float* cpool = KIN(4);
        for (int t = gw; t < 2048 + 16; t += ngw) {
            if (t < 2048) { const int b = t >> 6, c = (t >> 1) & 31, hs = t & 1; pool_task(U, PL, b * SEQ, SEQ, 64 * c, hs, 0, nullptr, lane); }
            else { const int b = (t - 2048) >> 1, hs = t & 1; pool_task(U, PL, MP + b * SSEQ, SSEQ, 0, hs, 4096, cpool + (size_t)b * 15 * DM, lane); }
        }
        for (int i = blockIdx.x * NTHREADS + TID; i < 40 * 15 * 256; i += gridDim.x * NTHREADS) {
            const int c4 = i & 255, r = (i >> 8) % 15, s = i / (15 * 256);
            const int row = s < 32 ? s * SEQ + SEQ - 15 + r : MP + (s - 32) * SSEQ + SSEQ - 15 + r;
            const u32x2 w = *(const u32x2*)(U + (size_t)row * DM + 4 * c4);
            float* dst = s < 32 ? out + O_POOLP + ((size_t)s * 15 + r) * DM + 4 * c4 : out + O_POOLS + ((size_t)(s - 32) * 15 + r) * DM + 4 * c4;
            *(f32x4*)dst = (f32x4){bflo(w.x), bfhi(w.x), bflo(w.y), bfhi(w.y)};
        }
    }
    small_gemm16<SM_GATE0>(lds, WSP(WS_R1) + (size_t)MP * DINNER, WSP(WS_WPS), DINNER, WSP(WS_R2 + R2S), nullptr);
    { pg8::Gemm g{WSP(WS_R1), WSP(WS_WPS), MP, DM, DINNER}; pg8::StaticOrder S; S.init(MP, DM, gridDim.x, blockIdx.x); pg8::EpiGate<0> E{WSP(WS_R2 + R2S), nullptr};
      pg8::gemm_phase<pg8::EpiGate<0>, pg8::StaticOrder, true, true>(lds, g, S, E); }
    XBAR();
    small_gemm16<SM_GATE1>(lds, WSP(WS_R2 + 3 * R2S) + (size_t)MP * DM, WSP(WS_WCOMB), DM, WSP(WS_R2 + 2 * R2S), WSP(WS_R2 + R2S));
    { pg8::Gemm g{WSP(WS_R2 + 3 * R2S), WSP(WS_WCOMB), MP, DM, DM}; pg8::StaticOrder S; S.init(MP, DM, gridDim.x, blockIdx.x); pg8::EpiGate<1> E{WSP(WS_R2 + 2 * R2S), WSP(WS_R2 + R2S)};
      pg8::gemm_phase<pg8::EpiGate<1>, pg8::StaticOrder, true, true>(lds, g, S, E); }
    XBAR();
    small_gemm16<SM_BF16>(lds, WSP(WS_R2 + 2 * R2S) + (size_t)MP * DM, WSP(WS_WOUT), DM, WSP(WS_R1), nullptr);
    { pg8::Gemm g{WSP(WS_R2 + 2 * R2S), WSP(WS_WOUT), MP, DM, DM}; pg8::StaticOrder S; S.init(MP, DM, gridDim.x, blockIdx.x); pg8::EpiBf16 E{WSP(WS_R1), DM};
      pg8::gemm_phase<pg8::EpiBf16, pg8::StaticOrder, true, true>(lds, g, S, E); }
    XBAR();
    { const int lane = LANE, gw = GW, ngw = NGW; const float* gp = KIN(11); float* out = KOUT; const bf16_t* F = WSP(WS_R1); bf16_t* XB = WSP(WS_XB);
      for (int m = 4 * gw; m < MV; m += 4 * ngw) post_rows2<4, false>(XB + (size_t)m * DM, (float*)(KWS + WS_RN) + m, F + (size_t)m * DM, gp, 1.0f, nullptr, lane); }
    XBAR();
    small_gemm<SM_SWIGLU>(lds, WSP(WS_XB) + (size_t)MP * DM, WSP(WS_WGU2), 2 * DFF, DM, WSP(WS_R2), nullptr, nullptr, nullptr);
    { pg8::Gemm g{WSP(WS_XB), WSP(WS_WGU2), MP, 2 * DFF, DM}; pg8::StaticOrder S; S.init(MP, 2 * DFF, gridDim.x, blockIdx.x); pg8::EpiSwiglu E{WSP(WS_R2), DFF};
      pg8::gemm_phase<pg8::EpiSwiglu, pg8::StaticOrder, true, true>(lds, g, S, E); }
    XBAR();
    small_gemm16<SM_BF16>(lds, WSP(WS_R2) + (size_t)MP * DFF, WSP(WS_WD2), DFF, WSP(WS_R1), nullptr);
    { pg8::Gemm g{WSP(WS_R2), WSP(WS_WD2), MP, DM, DFF, 1}; pg8::StaticOrder S; S.init(MP, DM, gridDim.x, blockIdx.x); pg8::EpiBf16 E{WSP(WS_R1), DM};
      pg8::gemm_phase<pg8::EpiBf16, pg8::StaticOrder, true, true>(lds, g, S, E); }
    XBAR();
    { const int lane = LANE, gw = GW, ngw = NGW; const float* gp = KIN(25); float* out = KOUT; const bf16_t* F = WSP(WS_R1);
      for (int m = 4 * gw; m < MV; m += 4 * ngw) post_rows2<4, true>(WSP(WS_XB) + (size_t)m * DM, (float*)(KWS + WS_RN) + m, F + (size_t)m * DM, gp, 0.5f, out + (size_t)m * DM, lane); }
}

extern "C" void kernel_launch(void* const* d_in, const int* in_sizes, int n_in, void* d_out, int out_size, void* d_ws, size_t ws_size, hipStream_t stream) {
    static int grid = 0;
    if (grid == 0) {
        if (n_in != 29 || ws_size < WS_END) { fprintf(stderr, "kernel_launch: unexpected n_in %d / ws_size %zu (need %zu)\n", n_in, ws_size, (size_t)WS_END); grid = -1; return; }
        int dev = 0, cus = 0, per_cu = 0;
        hipGetDevice(&dev); hipDeviceGetAttribute(&cus, hipDeviceAttributeMultiprocessorCount, dev);
        if (hipFuncSetAttribute((const void*)hybrid_fwd, hipFuncAttributeMaxDynamicSharedMemorySize, LDS_BYTES) != hipSuccess) { fprintf(stderr, "kernel_launch: hipFuncSetAttribute failed\n"); grid = -1; return; }
        if (hipOccupancyMaxActiveBlocksPerMultiprocessor(&per_cu, (const void*)hybrid_fwd, NTHREADS, LDS_BYTES) != hipSuccess || per_cu < 1) { fprintf(stderr, "kernel_launch: occupancy query says %d\n", per_cu); per_cu = 1; }
        (void)hipGetLastError();
        grid = cus * (per_cu > 1 ? 1 : per_cu);
        fprintf(stderr, "kernel_launch: grid %d (cus %d, per_cu %d), ws %zu\n", grid, cus, per_cu, ws_size);
    }
    if (grid < 0) return;
    Params p{};
    for (int i = 0; i < 29; ++i) p.in[i] = (const float*)d_in[i];
    p.out = (float*)d_out; p.ws = (unsigned char*)d_ws;
    void* args[] = {&p};
    hipError_t e = hipLaunchCooperativeKernel((const void*)hybrid_fwd, dim3(grid), dim3(NTHREADS), args, LDS_BYTES, stream);
    if (e != hipSuccess) fprintf(stderr, "kernel_launch: cooperative launch failed: %s (grid %d)\n", hipGetErrorString(e), grid);
}
```
